# Optimizing an MI355X kernel written in HIP

```python
import jax, jax.numpy as jnp
from jax import lax
import numpy as np

D_MODEL = 1024
BATCH = 32
SEQ = 256
DEPTH = 4
DEC_BATCH = 2
DEC_SEQ = 1024
PAST_LEN = 512

GRID_W = 64
N_AB = (DEPTH + 1) // 2
N_C = DEPTH // 2
EPS = 1e-6
ROPE_THETA = 10000.0
Q_BLOCK = 128
GLA_HEADS = 4
GLA_DK = 64
GLA_DV = 128
GLA_QK = GLA_HEADS * GLA_DK
GLA_V = GLA_HEADS * GLA_DV
GLA_RANK = 16
GLA_TAU = 16.0
GLA_CHUNK = 64
MLA_HEADS = 8
MLA_Q_RANK = 384
MLA_KV_RANK = 256
MLA_NOPE = 64
MLA_ROPE = 32
MLA_QK = MLA_NOPE + MLA_ROPE
MLA_V = 64
GQA_HEADS = 16
GQA_KV_HEADS = 4
GQA_DH = 64
C_OUT = GQA_HEADS * GQA_DH
MIX_WIDTH = GLA_V + MLA_HEADS * MLA_V
AB_WIDTHS = (GLA_QK, GLA_QK, GLA_V, GLA_V, 2 * GLA_RANK, MLA_Q_RANK, MLA_KV_RANK, MLA_ROPE)
AB_IN = GLA_QK * 2 + GLA_V * 2 + 2 * GLA_RANK + MLA_Q_RANK + MLA_KV_RANK + MLA_ROPE
C_WIDTHS = (GQA_HEADS * GQA_DH, GQA_KV_HEADS * GQA_DH, GQA_KV_HEADS * GQA_DH)
C_IN = GQA_HEADS * GQA_DH + 2 * GQA_KV_HEADS * GQA_DH
FFN_HIDDEN = -(-(8 * D_MODEL) // (3 * 256)) * 256

kernel_name = 'hybrid_diffusion_prefix_trunk_step'

F32 = jnp.float32


def split_cols(x, widths):
    offs, acc = [], 0
    for w in widths[:-1]:
        acc += w
        offs.append(acc)
    return jnp.split(x, offs, axis=-1)


def rms_norm(x, g):
    xf = x.astype(F32)
    y = xf * lax.rsqrt(jnp.mean(xf * xf, axis=-1, keepdims=True) + EPS)
    return (y * g.astype(F32)).astype(x.dtype)


def modulate(x, g, shift, scale):
    return rms_norm(x, g) * (1 + scale) + shift


def adaln(cond, w, b):
    m = jnp.einsum('...d,de->...e', jax.nn.silu(cond), w) + b
    return jnp.split(m[..., None, :], 6, axis=-1)


def axial_rope_tables(n_tok, d_rot):
    t = jnp.arange(n_tok, dtype=jnp.int32)
    pos = jnp.stack([t // GRID_W, t % GRID_W], axis=-1).astype(F32)
    quarter = d_rot // 4
    inv = jnp.power(ROPE_THETA, -jnp.arange(quarter, dtype=F32) / quarter)
    ang = pos[:, :, None] * inv
    return jnp.cos(ang), jnp.sin(ang)


def apply_axial_rope(x, cos, sin):
    B, T, H, d = x.shape
    xr = x.astype(F32).reshape(B, T, H, 2, 2, d // 4)
    x1, x2 = xr[..., 0, :], xr[..., 1, :]
    c, s = cos[None, :, None], sin[None, :, None]
    out = jnp.stack([x1 * c - x2 * s, x1 * s + x2 * c], axis=-2)
    return out.reshape(B, T, H, d).astype(x.dtype)


def rope_tail(x, cos, sin, start):
    return jnp.concatenate([x[..., :start], apply_axial_rope(x[..., start:], cos, sin)], axis=-1)


def block_attention(q, k, v):
    B, T, H, dh = q.shape
    Hkv, dv = k.shape[2], v.shape[-1]
    G = H // Hkv
    nb = T // Q_BLOCK
    scale = dh ** -0.5
    qb = q.reshape(B, nb, Q_BLOCK, Hkv, G, dh).transpose(1, 0, 2, 3, 4, 5)

    def one_block(qi):
        s = jnp.einsum('bqkgd,bskd->bkgqs', qi, k, preferred_element_type=F32) * scale
        p = jax.nn.softmax(s, axis=-1)
        return jnp.einsum('bkgqs,bskv->bqkgv', p.astype(v.dtype), v)

    o = lax.map(one_block, qb)
    return o.transpose(1, 0, 2, 3, 4, 5).reshape(B, T, H, dv)


def gla_chunk_scan(q, k, v, log_a, s0):
    B, T, H, dk = q.shape
    dv = v.shape[-1]
    C = GLA_CHUNK
    nc = T // C

    def rs(x):
        return x.astype(F32).reshape(B, nc, C, H, x.shape[-1]).transpose(1, 0, 3, 2, 4)

    qc, kc, vc, ac = rs(q), rs(k), rs(v), rs(log_a)
    b = jnp.cumsum(ac, axis=3)
    b_ref = b[:, :, :, C // 2 - 1:C // 2]
    b_last = b[:, :, :, C - 1:C]
    q_loc = qc * jnp.exp(b - b_ref)
    k_loc = kc * jnp.exp(b_ref - b)
    a_intra = jnp.einsum('nbhtd,nbhsd->nbhts', q_loc, k_loc)
    causal = jnp.tril(jnp.ones((C, C), dtype=bool))
    a_intra = jnp.where(causal, a_intra, 0.0)
    o_intra = jnp.einsum('nbhts,nbhsv->nbhtv', a_intra, vc)
    q_in = qc * jnp.exp(b)
    k_st = kc * jnp.exp(b_last - b)

    def step(S, inp):
        qi, ki, vi, bl = inp
        o = jnp.einsum('bhtd,bhdv->bhtv', qi, S)
        S = S * jnp.exp(bl)[:, :, 0, :, None] + jnp.einsum('bhsd,bhsv->bhdv', ki, vi)
        return S, o

    s_fin, o_inter = lax.scan(step, s0, (q_in, k_st, vc, b_last))
    o = (o_intra + o_inter).transpose(1, 0, 3, 2, 4).reshape(B, T, H, dv)
    return o, s_fin


def gla_prepare(q, k, v, a_lo, a_w2, a_b):
    B, T, _ = q.shape
    q = q.reshape(B, T, GLA_HEADS, GLA_DK) * (GLA_DK ** -0.5)
    k = k.reshape(B, T, GLA_HEADS, GLA_DK)
    v = v.reshape(B, T, GLA_HEADS, GLA_DV)
    logit = jnp.einsum('btzr,zre->btze', a_lo.reshape(B, T, 2, GLA_RANK), a_w2) + a_b
    log_a = (jax.nn.log_sigmoid(logit.astype(F32)) / GLA_TAU).reshape(B, T, 2, GLA_HEADS, GLA_DK)
    return q, k, v, log_a[:, :, 0], log_a[:, :, 1]


def gla_bidirectional(q, k, v, la_fwd, la_bwd, s0):
    o_f, s_f = gla_chunk_scan(q, k, v, la_fwd, s0[:, 0])
    fl = lambda a: jnp.flip(a, axis=1)
    o_b, s_b = gla_chunk_scan(fl(q), fl(k), fl(v), fl(la_bwd), s0[:, 1])
    return o_f + fl(o_b), jnp.stack([s_f, s_b], axis=1)


def gla_output(o, r, out_g):
    B, T = r.shape[:2]
    o = rms_norm(o.astype(r.dtype), out_g)
    return o.reshape(B, T, GLA_V) * jax.nn.silu(r)


def mla_queries(cq, q_norm_g, w_qb, qn_g):
    B, T, _ = cq.shape
    q = jnp.einsum('btr,re->bte', rms_norm(cq, q_norm_g), w_qb).reshape(B, T, MLA_HEADS, MLA_QK)
    return rms_norm(q, qn_g)


def mla_keys_values(ckv, kpe, w_kvb, kn_g):
    B, S, _ = ckv.shape
    kv = jnp.einsum('bsr,re->bse', ckv, w_kvb).reshape(B, S, MLA_HEADS, MLA_NOPE + MLA_V)
    k_nope, v = kv[..., :MLA_NOPE], kv[..., MLA_NOPE:]
    k_pe = jnp.broadcast_to(kpe[:, :, None, :], (B, S, MLA_HEADS, MLA_ROPE))
    k = rms_norm(jnp.concatenate([k_nope, k_pe], axis=-1), kn_g)
    return k, v


def ab_mixer_context(h, lp):
    B, T, _ = h.shape
    q, k, v, r, a_lo, cq, ckv, kpe = split_cols(jnp.einsum('btd,de->bte', h, lp['w_in']), AB_WIDTHS)
    qg, kg, vg, la_f, la_b = gla_prepare(q, k, v, a_lo, lp['a_w2'], lp['a_b'])
    s0 = jnp.zeros((B, 2, GLA_HEADS, GLA_DK, GLA_DV), F32)
    o_gla, gla_state = gla_bidirectional(qg, kg, vg, la_f, la_b, s0)
    o_gla = gla_output(o_gla, r, lp['gla_out_g'])
    ckv = rms_norm(ckv, lp['kv_norm_g'])
    qm = mla_queries(cq, lp['q_norm_g'], lp['w_qb'], lp['qn_g'])
    km, vm = mla_keys_values(ckv, kpe, lp['w_kvb'], lp['kn_g'])
    o_mla = block_attention(qm, km, vm).reshape(B, T, MLA_HEADS * MLA_V)
    out = jnp.einsum('bte,ed->btd', jnp.concatenate([o_gla, o_mla], axis=-1), lp['w_out'])
    return out, ckv, kpe, gla_state.astype(h.dtype)


def ab_mixer_latent(h, lp, ckv_ctx, kpe_ctx, gla_ctx, cos, sin):
    B, T, _ = h.shape
    q, k, v, r, a_lo, cq, ckv, kpe = split_cols(jnp.einsum('btd,de->bte', h, lp['w_in']), AB_WIDTHS)
    qg, kg, vg, la_f, la_b = gla_prepare(q, k, v, a_lo, lp['a_w2'], lp['a_b'])
    o_gla, _ = gla_bidirectional(qg, kg, vg, la_f, la_b, gla_ctx.astype(F32))
    o_gla = gla_output(o_gla, r, lp['gla_out_g'])
    ckv = rms_norm(ckv, lp['kv_norm_g'])
    qm = rope_tail(mla_queries(cq, lp['q_norm_g'], lp['w_qb'], lp['qn_g']), cos, sin, MLA_NOPE)
    k_lat, v_lat = mla_keys_values(ckv, kpe, lp['w_kvb'], lp['kn_g'])
    k_lat = rope_tail(k_lat, cos, sin, MLA_NOPE)
    k_ctx, v_ctx = mla_keys_values(ckv_ctx, kpe_ctx, lp['w_kvb'], lp['kn_g'])
    km = jnp.concatenate([k_ctx, k_lat], axis=1)
    vm = jnp.concatenate([v_ctx, v_lat], axis=1)
    o_mla = block_attention(qm, km, vm).reshape(B, T, MLA_HEADS * MLA_V)
    return jnp.einsum('bte,ed->btd', jnp.concatenate([o_gla, o_mla], axis=-1), lp['w_out'])


def gqa_project(h, lp):
    B, T, _ = h.shape
    q, k, v = split_cols(jnp.einsum('btd,de->bte', h, lp['w_in']), C_WIDTHS)
    q = rms_norm(q.reshape(B, T, GQA_HEADS, GQA_DH), lp['qn_g'])
    k = rms_norm(k.reshape(B, T, GQA_KV_HEADS, GQA_DH), lp['kn_g'])
    return q, k, v.reshape(B, T, GQA_KV_HEADS, GQA_DH)


def c_mixer_context(h, lp):
    B, T, _ = h.shape
    q, k, v = gqa_project(h, lp)
    o = block_attention(q, k, v).reshape(B, T, C_OUT)
    return jnp.einsum('bte,ed->btd', o, lp['w_out']), k, v


def c_mixer_latent(h, lp, k_ctx, v_ctx, cos, sin):
    B, T, _ = h.shape
    q, k, v = gqa_project(h, lp)
    q = apply_axial_rope(q, cos, sin)
    k = apply_axial_rope(k, cos, sin)
    o = block_attention(q, jnp.concatenate([k_ctx, k], axis=1), jnp.concatenate([v_ctx, v], axis=1))
    return jnp.einsum('bte,ed->btd', o.reshape(B, T, C_OUT), lp['w_out'])


def swiglu(h, w_in, w_out):
    g, u = jnp.split(jnp.einsum('btd,de->bte', h, w_in), 2, axis=-1)
    return jnp.einsum('btf,fd->btd', jax.nn.silu(g) * u, w_out)


def setup_inputs(seed: int = 0) -> dict:
    key = jax.random.key(seed)
    ks = jax.random.split(key, 30)
    nrm = lambda k, shape, s: jax.random.normal(k, shape, F32) * s
    gain = lambda k, shape: 1.0 + 0.05 * jax.random.normal(k, shape, F32)
    D = D_MODEL
    return {
        'x_prompt': nrm(ks[0], (BATCH, SEQ, D), 1.0),
        'x_sample': nrm(ks[1], (DEC_BATCH, DEC_SEQ, D), 1.0),
        'c': nrm(ks[2], (DEC_BATCH, D), 1.0),
        'cache_mla_ckv': nrm(ks[3], (DEC_BATCH, N_AB, PAST_LEN, MLA_KV_RANK), 1.0),
        'cache_mla_kpe': nrm(ks[4], (DEC_BATCH, N_AB, PAST_LEN, MLA_ROPE), 1.0),
        'state_gla': nrm(ks[5], (DEC_BATCH, N_AB, 2, GLA_HEADS, GLA_DK, GLA_DV), 1.0),
        'cache_gqa_k': nrm(ks[6], (DEC_BATCH, N_C, PAST_LEN, GQA_KV_HEADS, GQA_DH), 1.0),
        'cache_gqa_v': nrm(ks[7], (DEC_BATCH, N_C, PAST_LEN, GQA_KV_HEADS, GQA_DH), 1.0),
        'c_ctx': nrm(ks[8], (D,), 1.0),
        'ada_w': nrm(ks[9], (DEPTH, D, 6 * D), D ** -0.5),
        'ada_b': nrm(ks[10], (DEPTH, 6 * D), 0.01),
        'norm_mix_g': gain(ks[11], (DEPTH, D)),
        'norm_ffn_g': gain(ks[12], (DEPTH, D)),
        'ffn_w_in': nrm(ks[13], (DEPTH, D, 2 * FFN_HIDDEN), D ** -0.5),
        'ffn_w_out': nrm(ks[14], (DEPTH, FFN_HIDDEN, D), FFN_HIDDEN ** -0.5),
        'ab_w_in': nrm(ks[15], (N_AB, D, AB_IN), D ** -0.5),
        'ab_w_out': nrm(ks[16], (N_AB, MIX_WIDTH, D), MIX_WIDTH ** -0.5),
        'gla_a_w2': nrm(ks[17], (N_AB, 2, GLA_RANK, GLA_QK), GLA_RANK ** -0.5),
        'gla_a_b': nrm(ks[18], (N_AB, 2, GLA_QK), 0.1),
        'gla_out_g': gain(ks[19], (N_AB, GLA_DV)),
        'mla_q_norm_g': gain(ks[20], (N_AB, MLA_Q_RANK)),
        'mla_w_qb': nrm(ks[21], (N_AB, MLA_Q_RANK, MLA_HEADS * MLA_QK), MLA_Q_RANK ** -0.5),
        'mla_kv_norm_g': gain(ks[22], (N_AB, MLA_KV_RANK)),
        'mla_w_kvb': nrm(ks[23], (N_AB, MLA_KV_RANK, MLA_HEADS * (MLA_NOPE + MLA_V)), MLA_KV_RANK ** -0.5),
        'mla_qn_g': gain(ks[24], (N_AB, MLA_QK)),
        'mla_kn_g': gain(ks[25], (N_AB, MLA_QK)),
        'gqa_w_in': nrm(ks[26], (N_C, D, C_IN), D ** -0.5),
        'gqa_w_out': nrm(ks[27], (N_C, C_OUT, D), C_OUT ** -0.5),
        'gqa_qn_g': gain(ks[28], (N_C, GQA_DH)),
        'gqa_kn_g': gain(ks[29], (N_C, GQA_DH)),
    }


def reference(x_prompt, x_sample, c, cache_mla_ckv, cache_mla_kpe, state_gla, cache_gqa_k, cache_gqa_v,
              c_ctx, ada_w, ada_b, norm_mix_g, norm_ffn_g, ffn_w_in, ffn_w_out, ab_w_in, ab_w_out,
              gla_a_w2, gla_a_b, gla_out_g, mla_q_norm_g, mla_w_qb, mla_kv_norm_g, mla_w_kvb, mla_qn_g,
              mla_kn_g, gqa_w_in, gqa_w_out, gqa_qn_g, gqa_kn_g):
    rows = x_sample.shape[1] // GRID_W
    n_lat = rows * GRID_W
    cos_mla, sin_mla = axial_rope_tables(n_lat, MLA_ROPE)
    cos_gqa, sin_gqa = axial_rope_tables(n_lat, GQA_DH)
    xp, xs = x_prompt, x_sample
    new_ckv, new_kpe, new_gla, new_k, new_v = [], [], [], [], []
    for l in range(DEPTH):
        i = l // 2
        mp = adaln(c_ctx, ada_w[l], ada_b[l])
        ms = adaln(c, ada_w[l], ada_b[l])
        hp = modulate(xp, norm_mix_g[l], mp[0], mp[1])
        hs = modulate(xs, norm_mix_g[l], ms[0], ms[1])
        if l % 2 == 0:
            lp = {'w_in': ab_w_in[i], 'w_out': ab_w_out[i], 'a_w2': gla_a_w2[i], 'a_b': gla_a_b[i],
                  'gla_out_g': gla_out_g[i], 'q_norm_g': mla_q_norm_g[i], 'w_qb': mla_w_qb[i],
                  'kv_norm_g': mla_kv_norm_g[i], 'w_kvb': mla_w_kvb[i], 'qn_g': mla_qn_g[i], 'kn_g': mla_kn_g[i]}
            op, ckv, kpe, gst = ab_mixer_context(hp, lp)
            os_ = ab_mixer_latent(hs, lp, cache_mla_ckv[:, i], cache_mla_kpe[:, i], state_gla[:, i],
                                  cos_mla, sin_mla)
            new_ckv.append(ckv)
            new_kpe.append(kpe)
            new_gla.append(gst)
        else:
            lp = {'w_in': gqa_w_in[i], 'w_out': gqa_w_out[i], 'qn_g': gqa_qn_g[i], 'kn_g': gqa_kn_g[i]}
            op, kc, vc = c_mixer_context(hp, lp)
            os_ = c_mixer_latent(hs, lp, cache_gqa_k[:, i], cache_gqa_v[:, i], cos_gqa, sin_gqa)
            new_k.append(kc)
            new_v.append(vc)
        xp = xp + mp[2] * op
        xs = xs + ms[2] * os_
        hp = modulate(xp, norm_ffn_g[l], mp[3], mp[4])
        hs = modulate(xs, norm_ffn_g[l], ms[3], ms[4])
        xp = xp + mp[5] * swiglu(hp, ffn_w_in[l], ffn_w_out[l])
        xs = xs + ms[5] * swiglu(hs, ffn_w_in[l], ffn_w_out[l])
    return (xp, xs, jnp.stack(new_ckv, axis=1), jnp.stack(new_kpe, axis=1), jnp.stack(new_gla, axis=1),
            jnp.stack(new_k, axis=1), jnp.stack(new_v, axis=1))
```

```cpp
#include <hip/hip_runtime.h>
#include <hip/hip_cooperative_groups.h>
#include <cstdio>
namespace cg = cooperative_groups;

#ifndef PROBE_MASK
#define PROBE_MASK 0
#endif
#ifndef MULTI_LAUNCH
#define MULTI_LAUNCH 0
#endif

#define DI __device__ __forceinline__
#define LAS __attribute__((address_space(3)))
typedef unsigned short bf16_t;
typedef short bf16x8 __attribute__((ext_vector_type(8)));
typedef short s16x4 __attribute__((ext_vector_type(4)));
typedef float f32x4 __attribute__((ext_vector_type(4)));
typedef unsigned u32x4 __attribute__((ext_vector_type(4)));
typedef unsigned u32x2 __attribute__((ext_vector_type(2)));

constexpr int MC = 8192, MLAT = 2048, M = 10240, MKV = 11264;
constexpr int NTH = 512;
constexpr int LDS_BYTES = 131072;
constexpr float EPS = 1e-6f;
constexpr float LOG2E = 1.4426950408889634f;

constexpr size_t O_CKV = 10485760, O_KPE = 14680064, O_GLA = 15204352, O_K = 19398656, O_V = 23592960;

constexpr size_t al256(size_t x) { return (x + 255) & ~(size_t)255; }
constexpr size_t W_MOD = 0;
constexpr size_t W_H = al256(W_MOD + 3 * 4 * 6144 * 4);
constexpr size_t W_PROJ = al256(W_H + (size_t)M * 1024 * 2);
constexpr size_t W_QP = al256(W_PROJ + (size_t)M * 2304 * 2);
constexpr size_t W_KP = al256(W_QP + (size_t)M * 1024 * 2);
constexpr size_t W_VT = al256(W_KP + (size_t)MKV * 768 * 2);
constexpr size_t W_MIX = al256(W_VT + (size_t)MKV * 512 * 2);
constexpr size_t W_LA = al256(W_MIX + (size_t)M * 1024 * 2);
constexpr size_t W_ODIR = al256(W_LA + (size_t)2 * M * 256 * 4);
constexpr size_t W_FFNH = al256(W_ODIR + (size_t)2 * M * 512 * 4);
constexpr size_t W_KVM = W_FFNH;
constexpr size_t W_QM = al256(W_KVM + (size_t)MKV * 1024 * 2);
constexpr size_t W_CQN = al256(W_QM + (size_t)M * 768 * 2);
constexpr size_t W_CKVN = al256(W_CQN + (size_t)M * 384 * 2);
constexpr size_t W_ALIAS_END = al256(W_CKVN + (size_t)MKV * 256 * 2);
constexpr size_t W_FFNH_END = al256(W_FFNH + (size_t)M * 2816 * 2);
static_assert(W_ALIAS_END <= W_FFNH_END, "alias overflow");
constexpr size_t W_FFI = W_FFNH_END;
constexpr size_t W_FFO = al256(W_FFI + (size_t)4 * 5632 * 1024 * 2);
constexpr size_t W_ABI = al256(W_FFO + (size_t)4 * 1024 * 2816 * 2);
constexpr size_t W_ABO = al256(W_ABI + (size_t)2 * 2304 * 1024 * 2);
constexpr size_t W_QB = al256(W_ABO + (size_t)2 * 1024 * 1024 * 2);
constexpr size_t W_KVB = al256(W_QB + (size_t)2 * 768 * 384 * 2);
constexpr size_t W_GQI = al256(W_KVB + (size_t)2 * 1024 * 256 * 2);
constexpr size_t W_GQO = al256(W_GQI + (size_t)2 * 1536 * 1024 * 2);
constexpr size_t W_END = al256(W_GQO + (size_t)2 * 1024 * 1024 * 2);
constexpr size_t W_BAR = W_END;
constexpr size_t W_RSS = W_BAR + 16384;
constexpr size_t W_BIASI = al256(W_RSS + (size_t)8 * M * 4);
constexpr size_t W_BIASF = al256(W_BIASI + (size_t)4 * 3 * 2304 * 4);
constexpr size_t W_GST = al256(W_BIASF + (size_t)4 * 3 * 5632 * 4);
constexpr size_t W_END2 = al256(W_GST + (size_t)16 * 512 * 16 * 4);
static_assert(W_END2 <= (size_t)402653184, "workspace too large");

struct P { const float* in[30]; float* out; char* ws; };

DI unsigned pk(float lo, float hi) { unsigned r; asm("v_cvt_pk_bf16_f32 %0, %1, %2" : "=v"(r) : "v"(lo), "v"(hi)); return r; }
DI float bf2f(bf16_t b) { return __uint_as_float((unsigned)b << 16); }
DI float bflo(unsigned u) { return __uint_as_float(u << 16); }
DI float bfhi(unsigned u) { return __uint_as_float(u & 0xffff0000u); }
DI bf16_t f2bf(float x) { return (bf16_t)(pk(x, 0.f) & 0xffffu); }
DI float silu_f(float x) { return x * __builtin_amdgcn_rcpf(1.f + __expf(-x)); }
DI f32x4 mfma16(bf16x8 a, bf16x8 b, f32x4 c) { return __builtin_amdgcn_mfma_f32_16x16x32_bf16(a, b, c, 0, 0, 0); }
DI int tid_o() { int t = threadIdx.x; asm volatile("" : "+v"(t)); return t; }
DI int bid_o() { int t = blockIdx.x; asm volatile("" : "+s"(t)); return t; }
DI float wave_sum(float v) {
#pragma unroll
    for (int o = 1; o < 64; o <<= 1) v += __shfl_xor(v, o);
    return v;
}


#define XB_TMO      128
#define XB_XCNT(j)  (256  + 64 * (j))
#define XB_XSUB(j)  (1280 + 64 * (j))
#define XB_XGEN(j)  (2304 + 64 * (j))
#define XB_TOP      3328
#define XB_TOPGEN   3392
#define XCD_BAR_WORDS 3456
#define XB_SPIN_CAP (1u << 20)
DI unsigned xb_ld(unsigned* p)              { return __hip_atomic_load(p, __ATOMIC_RELAXED, __HIP_MEMORY_SCOPE_AGENT); }
DI unsigned xb_add(unsigned* p, unsigned v) { return __hip_atomic_fetch_add(p, v, __ATOMIC_RELAXED, __HIP_MEMORY_SCOPE_AGENT); }
DI unsigned xb_xcc_id() { return (unsigned)__builtin_amdgcn_s_getreg((3 << 11) | 20) & 0xFu; }
#define XB_SPIN(cond, bar) do { unsigned _sp = 0; while (cond) { __builtin_amdgcn_s_sleep(1); \
    if ((++_sp & 255u) == 0u) { if (xb_ld(&(bar)[XB_TMO])) break; if (_sp > XB_SPIN_CAP) { atomicAdd(&(bar)[XB_TMO], 1u); break; } } } } while (0)
struct XcdBarrier { unsigned* bar; unsigned x; volatile LAS unsigned* st; };
DI XcdBarrier xcd_barrier_post(unsigned* bar, volatile LAS unsigned* st) {
    XcdBarrier b; b.bar = bar; b.x = xb_xcc_id(); b.st = st;
    if (threadIdx.x == 0) (void)xb_add(&bar[XB_XCNT(b.x)], 1u);
    return b;
}
DI void xcd_barrier_complete(unsigned* bar, unsigned x, unsigned& nloc, unsigned& nx) {
    const unsigned G = gridDim.x * gridDim.y * gridDim.z;
    unsigned sum, cnt, mine, sp = 0u;
    for (;;) {
        sum = 0u; cnt = 0u; mine = 0u;
#pragma unroll
        for (unsigned j = 0; j < 16; ++j) { const unsigned c = xb_ld(&bar[XB_XCNT(j)]); sum += c; cnt += (c > 0u) ? 1u : 0u; mine = (j == x) ? c : mine; }
        if (sum == G) break;
        __builtin_amdgcn_s_sleep(1);
        if ((++sp & 255u) == 0u) { if (xb_ld(&bar[XB_TMO])) break; if (sp > XB_SPIN_CAP) { atomicAdd(&bar[XB_TMO], 1u); break; } }
    }
    nloc = mine > 0u ? mine : 1u; nx = cnt > 0u ? cnt : 1u;
}
DI void xcd_barrier(const XcdBarrier& b) {
    asm volatile("s_waitcnt vmcnt(0)" ::: "memory");
    __syncthreads();
    if (threadIdx.x == 0) {
        unsigned* bar = b.bar;
        __builtin_amdgcn_s_waitcnt(0);
        unsigned nloc = b.st[0], nx = b.st[1];
        if (nloc == 0u) { xcd_barrier_complete(bar, b.x, nloc, nx); b.st[0] = nloc; b.st[1] = nx; }
        const unsigned old = xb_add(&bar[XB_XSUB(b.x)], 1u);
        const unsigned gen = old / nloc;
        if (old + 1u == (gen + 1u) * nloc) {
            __builtin_amdgcn_fence(__ATOMIC_RELEASE, "agent");
            asm volatile("s_waitcnt vmcnt(0)" ::: "memory");
            const unsigned og = xb_add(&bar[XB_TOP], 1u);
            const unsigned tg = og / nx;
            if (og + 1u == (tg + 1u) * nx) xb_add(&bar[XB_TOPGEN], 1u);
            else XB_SPIN(xb_ld(&bar[XB_TOPGEN]) == tg, bar);
            __builtin_amdgcn_fence(__ATOMIC_ACQUIRE, "agent");
            xb_add(&bar[XB_XGEN(b.x)], 1u);
            asm volatile("s_waitcnt vmcnt(0)" ::: "memory");
        } else {
            XB_SPIN(xb_ld(&bar[XB_XGEN(b.x)]) == gen, bar);
            __builtin_amdgcn_fence(__ATOMIC_ACQUIRE, "agent");
            asm volatile("s_waitcnt vmcnt(0)" ::: "memory");
        }
    }
    __syncthreads();
}

namespace pg8 {
constexpr int BM = 256, BK = 64, HALF = 128, HTB = HALF * BK * 2, STAGE_BYTES = 8 * HTB, NXCD = 8, WGM = 8;
DI int lds_byte(int r, int c) { const int st = (r >> 4) * 2 + (c >> 5), rr = r & 15, cc = c & 31, ob = rr * 64 + cc * 2; return st * 1024 + (ob ^ (((ob >> 9) & 1) << 5)); }
DI void stage_rc(int b, int& R, int& C) { const int st = b / 1024, sb = b % 1024, swz = sb ^ (((sb >> 9) & 1) << 5); R = (st >> 1) * 16 + swz / 64; C = (st & 1) * 32 + (swz % 64) / 2; }
DI int perm32(int rho) { const int n = rho >> 4, i = rho & 15; return 8 * (i >> 2) + 4 * n + (i & 3); }
struct Unit { int pm, pn; };
struct Gemm { const bf16_t* A; const bf16_t* Bt; int M, N, K; };
struct StaticOrder {
    int nM, nN, nwg, G, c;
    DI void init(int M_, int N_, int G_, int c_) { nM = M_ / BM; nN = N_ / BM; nwg = nM * nN; G = G_; c = c_; }
    DI bool next(int i, Unit& u) const {
        const long L = (long)i * G + c; if (L >= nwg) return false;
        int wgid = (int)L; { const int q = nwg / NXCD, r = nwg % NXCD, xcd = wgid % NXCD, off = wgid / NXCD; wgid = (xcd < r ? xcd * (q + 1) : r * (q + 1) + (xcd - r) * q) + off; }
        const int nig = WGM * nN, gid = wgid / nig, fm = gid * WGM, gsz = (nM - fm) < WGM ? (nM - fm) : WGM;
        u.pm = fm + ((wgid % nig) % gsz); u.pn = (wgid % nig) / gsz; return true;
    }
};

template <class Epi>
DI void gemm_phase(LAS unsigned char* lds, const Gemm g, const StaticOrder& S, const Epi& E) {
    const int tid = tid_o(), wid = __builtin_amdgcn_readfirstlane(tid >> 6), lane = tid & 63, wr = wid >> 2, wc = wid & 3, fr = lane & 15, fq = lane >> 4;
    const int K = g.K, nt = K / BK;
    unsigned voffA[2], voffB[2];
#pragma unroll
    for (int i = 0; i < 2; ++i) { int R, C; stage_rc(tid * 16 + i * 8192, R, C); const int Rb = Epi::PERM ? ((R & ~31) + perm32(R & 31)) : R;
        voffA[i] = (unsigned)(R * K + C) * 2u; voffB[i] = (unsigned)(Rb * K + C) * 2u; }
    const size_t kstep = (size_t)(BK * 2);
    const size_t hstep = (size_t)HALF * K * 2;
    const size_t tstep = 2 * hstep;
    const unsigned ldsw = (unsigned)wid * 1024u;
    const int aoff = lds_byte(wr * 64 + fr, fq * 8), boff = lds_byte(wc * 32 + fr, fq * 8);
#define PG8_SA(b, h) (((b) * 2 + (h)) * HTB)
#define PG8_SB(b, h) ((4 + (b) * 2 + (h)) * HTB)
#define PG8_STAGE(bufoff, gbase, voff) do { _Pragma("unroll") for (int _i = 0; _i < 2; ++_i) \
        __builtin_amdgcn_global_load_lds((const unsigned*)((const char*)(gbase) + (voff)[_i]), (LAS unsigned*)(lds + (bufoff) + ldsw + _i * 8192), 16, 0, 0); } while (0)
#define PG8_LDA(dst, b, h) do { _Pragma("unroll") for (int m = 0; m < 4; ++m) _Pragma("unroll") for (int k = 0; k < 2; ++k) dst[m][k] = *(const LAS bf16x8*)(lds + PG8_SA(b, h) + aoff + m * 2048 + k * 1024); } while (0)
#define PG8_LDB(dst, b, h) do { _Pragma("unroll") for (int n = 0; n < 2; ++n) _Pragma("unroll") for (int k = 0; k < 2; ++k) dst[n][k] = *(const LAS bf16x8*)(lds + PG8_SB(b, h) + boff + n * 2048 + k * 1024); } while (0)
#define PG8_MMA(ai, bj, At, Bt) do { __builtin_amdgcn_s_setprio(1); _Pragma("unroll") for (int m = 0; m < 4; ++m) _Pragma("unroll") for (int n = 0; n < 2; ++n) _Pragma("unroll") for (int k = 0; k < 2; ++k) \
        acc[ai][bj][m][n] = __builtin_amdgcn_mfma_f32_16x16x32_bf16(Bt[n][k], At[m][k], acc[ai][bj][m][n], 0, 0, 0); __builtin_amdgcn_s_setprio(0); } while (0)
#define PG8_WAIT_V(n) asm volatile("s_waitcnt vmcnt(" #n ")" ::: "memory")
#define PG8_WAIT_L(n) asm volatile("s_waitcnt lgkmcnt(" #n ")" ::: "memory")
#define PG8_BAR __builtin_amdgcn_s_barrier()
#define PG8_SCHED __builtin_amdgcn_sched_barrier(0)
    Unit cur, nxt; int ui = 0;
    if (!S.next(0, cur)) return;
    f32x4 acc[2][2][4][2];
#pragma unroll
    for (int a = 0; a < 2; ++a)
#pragma unroll
        for (int b = 0; b < 2; ++b)
#pragma unroll
            for (int m = 0; m < 4; ++m)
#pragma unroll
                for (int n = 0; n < 2; ++n) acc[a][b][m][n] = (f32x4){0.f, 0.f, 0.f, 0.f};
    bf16x8 At[4][2], B0[2][2], B1[2][2];
    const char* cA = (const char*)g.A + (size_t)cur.pm * tstep; const char* cB = (const char*)g.Bt + (size_t)cur.pn * tstep;
    PG8_STAGE(PG8_SB(0, 0), cB, voffB); PG8_STAGE(PG8_SA(0, 0), cA, voffA); PG8_STAGE(PG8_SB(0, 1), cB + hstep, voffB); PG8_STAGE(PG8_SA(0, 1), cA + hstep, voffA);
    if (wr == 1) PG8_BAR;
    PG8_WAIT_V(4); PG8_BAR;
    PG8_STAGE(PG8_SB(1, 0), cB + kstep, voffB); PG8_STAGE(PG8_SA(1, 0), cA + kstep, voffA); PG8_STAGE(PG8_SB(1, 1), cB + hstep + kstep, voffB);
    PG8_WAIT_V(6); PG8_BAR;
    for (;;) {
        const bool has_next = S.next(ui + 1, nxt);
        const char* nA = has_next ? (const char*)g.A + (size_t)nxt.pm * tstep : cA; const char* nB = has_next ? (const char*)g.Bt + (size_t)nxt.pn * tstep : cB;
        for (int t = 0; t < nt; t += 2) {
            const bool last = (t == nt - 2);
            const char* a1 = cA + (size_t)(t + 1) * kstep;
            const char* a2 = last ? nA : cA + (size_t)(t + 2) * kstep; const char* b2 = last ? nB : cB + (size_t)(t + 2) * kstep;
            const char* a3 = a2 + kstep; const char* b3 = b2 + kstep;
            PG8_LDB(B0, 0, 0); PG8_SCHED; PG8_LDA(At, 0, 0); PG8_STAGE(PG8_SA(1, 1), a1 + hstep, voffA);
            PG8_WAIT_L(8); PG8_BAR; PG8_WAIT_L(0); PG8_MMA(0, 0, At, B0); PG8_BAR; PG8_SCHED;
            PG8_LDB(B1, 0, 1); PG8_STAGE(PG8_SB(0, 0), b2, voffB);
            PG8_BAR; PG8_WAIT_L(0); PG8_MMA(0, 1, At, B1); PG8_BAR;
            PG8_LDA(At, 0, 1); PG8_STAGE(PG8_SA(0, 0), a2, voffA);
            PG8_BAR; PG8_WAIT_L(0); PG8_MMA(1, 0, At, B0); PG8_BAR; PG8_SCHED;
            PG8_STAGE(PG8_SB(0, 1), b2 + hstep, voffB);
            PG8_WAIT_V(6); PG8_BAR; PG8_MMA(1, 1, At, B1); PG8_BAR;
            PG8_LDB(B0, 1, 0); PG8_SCHED; PG8_LDA(At, 1, 0); PG8_STAGE(PG8_SA(0, 1), a2 + hstep, voffA);
            PG8_WAIT_L(8); PG8_BAR; PG8_WAIT_L(0); PG8_MMA(0, 0, At, B0); PG8_BAR; PG8_SCHED;
            PG8_LDB(B1, 1, 1); PG8_STAGE(PG8_SB(1, 0), b3, voffB);
            PG8_BAR; PG8_WAIT_L(0); PG8_MMA(0, 1, At, B1); PG8_BAR;
            PG8_LDA(At, 1, 1); PG8_STAGE(PG8_SA(1, 0), a3, voffA);
            PG8_BAR; PG8_WAIT_L(0); PG8_MMA(1, 0, At, B0); PG8_BAR; PG8_SCHED;
            PG8_STAGE(PG8_SB(1, 1), b3 + hstep, voffB);
            PG8_WAIT_V(6); PG8_BAR; PG8_MMA(1, 1, At, B1); PG8_BAR;
        }
        E(acc, cur, wr, wc, fr, fq);
        if (!has_next) break;
#pragma unroll
        for (int a = 0; a < 2; ++a)
#pragma unroll
            for (int b = 0; b < 2; ++b)
#pragma unroll
                for (int m = 0; m < 4; ++m)
#pragma unroll
                    for (int n = 0; n < 2; ++n) acc[a][b][m][n] = (f32x4){0.f, 0.f, 0.f, 0.f};
        cur = nxt; cA = nA; cB = nB; ++ui;
    }
    PG8_WAIT_V(0);
    if (wr == 0) PG8_BAR;
    PG8_BAR;
#undef PG8_SA
#undef PG8_SB
#undef PG8_STAGE
#undef PG8_LDA
#undef PG8_LDB
#undef PG8_MMA
#undef PG8_WAIT_V
#undef PG8_WAIT_L
#undef PG8_BAR
#undef PG8_SCHED
}
}

struct EpiBf {
    static constexpr bool PERM = true;
    bf16_t* O; int ldc;
    DI void operator()(const f32x4 (&acc)[2][2][4][2], const pg8::Unit& u, int wr, int wc, int fr, int fq) const {
        const int row0 = u.pm * 256 + wr * 64 + fr, col0 = u.pn * 256 + wc * 32 + 8 * fq;
#pragma unroll
        for (int ai = 0; ai < 2; ++ai)
#pragma unroll
            for (int m = 0; m < 4; ++m) { bf16_t* rowp = O + (size_t)(row0 + ai * 128 + m * 16) * ldc + col0;
#pragma unroll
                for (int bj = 0; bj < 2; ++bj) { const f32x4 v0 = acc[ai][bj][m][0], v1 = acc[ai][bj][m][1];
                    u32x4 w; w.x = pk(v0[0], v0[1]); w.y = pk(v0[2], v0[3]); w.z = pk(v1[0], v1[1]); w.w = pk(v1[2], v1[3]);
                    *(u32x4*)(rowp + bj * 128) = w; } }
    }
};
struct EpiSwi {
    static constexpr bool PERM = true;
    bf16_t* O;
    DI void operator()(const f32x4 (&acc)[2][2][4][2], const pg8::Unit& u, int wr, int wc, int fr, int fq) const {
        const int row0 = u.pm * 256 + wr * 64 + fr, col0 = u.pn * 128 + wc * 32 + 8 * fq;
#pragma unroll
        for (int ai = 0; ai < 2; ++ai)
#pragma unroll
            for (int m = 0; m < 4; ++m) { bf16_t* rowp = O + (size_t)(row0 + ai * 128 + m * 16) * 2816 + col0;
                float r[8];
#pragma unroll
                for (int n = 0; n < 2; ++n)
#pragma unroll
                    for (int j = 0; j < 4; ++j) { const float g = acc[ai][0][m][n][j], uu = acc[ai][1][m][n][j]; r[n * 4 + j] = silu_f(g) * uu; }
                u32x4 w; w.x = pk(r[0], r[1]); w.y = pk(r[2], r[3]); w.z = pk(r[4], r[5]); w.w = pk(r[6], r[7]);
                *(u32x4*)rowp = w; }
    }
};
struct EpiRes {
    static constexpr bool PERM = false;
    float* X; const float* gate; const float* S0; const float* S1;
    DI void operator()(const f32x4 (&acc)[2][2][4][2], const pg8::Unit& u, int wr, int wc, int fr, int fq) const {
        const int row0 = u.pm * 256 + wr * 64 + fr, col0 = u.pn * 256 + wc * 32 + 4 * fq;
        const int grp = u.pm < 32 ? 0 : 1 + ((u.pm - 32) >> 2);
        const float* gp = gate + (size_t)grp * 4 * 6144 + col0;
        f32x4 gv[2][2];
#pragma unroll
        for (int bj = 0; bj < 2; ++bj)
#pragma unroll
            for (int n = 0; n < 2; ++n) gv[bj][n] = *(const f32x4*)(gp + bj * 128 + n * 16);
#pragma unroll
        for (int ai = 0; ai < 2; ++ai)
#pragma unroll
            for (int m = 0; m < 4; ++m) { const int row = row0 + ai * 128 + m * 16; float* rowp = X + (size_t)row * 1024 + col0;
                const float* srow = (u.pm < 32 ? S0 + (size_t)row * 1024 : S1 + (size_t)(row - MC) * 1024) + col0;
#pragma unroll
                for (int bj = 0; bj < 2; ++bj)
#pragma unroll
                    for (int n = 0; n < 2; ++n) { *(f32x4*)(rowp + bj * 128 + n * 16) = *(const f32x4*)(srow + bj * 128 + n * 16) + gv[bj][n] * acc[ai][bj][m][n]; } }
    }
};


struct EpiBfN {
    static constexpr bool PERM = true;
    bf16_t* O; int ldc; const float* rss; const float* bias; int gs;
    DI void operator()(const f32x4 (&acc)[2][2][4][2], const pg8::Unit& u, int wr, int wc, int fr, int fq) const {
        const int row0 = u.pm * 256 + wr * 64 + fr, col0 = u.pn * 256 + wc * 32 + 8 * fq;
        const int grp = u.pm < 32 ? 0 : 1 + ((u.pm - 32) >> 2);
        const float* bp = bias + (size_t)grp * gs + col0;
        f32x4 b[2][2];
#pragma unroll
        for (int bj = 0; bj < 2; ++bj)
#pragma unroll
            for (int n = 0; n < 2; ++n) b[bj][n] = *(const f32x4*)(bp + bj * 128 + 4 * n);
        float rsv[8];
#pragma unroll
        for (int k = 0; k < 8; ++k) rsv[k] = rss[row0 + (k >> 2) * 128 + (k & 3) * 16];
        asm volatile("" : "+v"(rsv[0]), "+v"(rsv[1]), "+v"(rsv[2]), "+v"(rsv[3]), "+v"(rsv[4]), "+v"(rsv[5]), "+v"(rsv[6]), "+v"(rsv[7]), "+v"(b[0][0]), "+v"(b[0][1]), "+v"(b[1][0]), "+v"(b[1][1]));
#pragma unroll
        for (int k = 0; k < 8; ++k) rsv[k] = rsqrtf(rsv[k] * (1.f / 1024.f) + EPS);
#pragma unroll
        for (int ai = 0; ai < 2; ++ai)
#pragma unroll
            for (int m = 0; m < 4; ++m) { const int row = row0 + ai * 128 + m * 16; bf16_t* rowp = O + (size_t)row * ldc + col0;
                const float rs = rsv[ai * 4 + m];
#pragma unroll
                for (int bj = 0; bj < 2; ++bj) { const f32x4 v0 = acc[ai][bj][m][0] * rs + b[bj][0], v1 = acc[ai][bj][m][1] * rs + b[bj][1];
                    u32x4 w; w.x = pk(v0[0], v0[1]); w.y = pk(v0[2], v0[3]); w.z = pk(v1[0], v1[1]); w.w = pk(v1[2], v1[3]);
                    *(u32x4*)(rowp + bj * 128) = w; } }
    }
};
struct EpiSwiN {
    static constexpr bool PERM = true;
    bf16_t* O; const float* rss; const float* bias;
    DI void operator()(const f32x4 (&acc)[2][2][4][2], const pg8::Unit& u, int wr, int wc, int fr, int fq) const {
        const int row0 = u.pm * 256 + wr * 64 + fr, col0 = u.pn * 128 + wc * 32 + 8 * fq;
        const int grp = u.pm < 32 ? 0 : 1 + ((u.pm - 32) >> 2);
        const float* bp = bias + (size_t)grp * 5632 + u.pn * 256 + wc * 32 + 8 * fq;
        f32x4 bg[2], bu[2];
#pragma unroll
        for (int n = 0; n < 2; ++n) { bg[n] = *(const f32x4*)(bp + 4 * n); bu[n] = *(const f32x4*)(bp + 128 + 4 * n); }
        float rsv[8];
#pragma unroll
        for (int k = 0; k < 8; ++k) rsv[k] = rss[row0 + (k >> 2) * 128 + (k & 3) * 16];
        asm volatile("" : "+v"(rsv[0]), "+v"(rsv[1]), "+v"(rsv[2]), "+v"(rsv[3]), "+v"(rsv[4]), "+v"(rsv[5]), "+v"(rsv[6]), "+v"(rsv[7]), "+v"(bg[0]), "+v"(bg[1]), "+v"(bu[0]), "+v"(bu[1]));
#pragma unroll
        for (int k = 0; k < 8; ++k) rsv[k] = rsqrtf(rsv[k] * (1.f / 1024.f) + EPS);
#pragma unroll
        for (int ai = 0; ai < 2; ++ai)
#pragma unroll
            for (int m = 0; m < 4; ++m) { const int row = row0 + ai * 128 + m * 16; bf16_t* rowp = O + (size_t)row * 2816 + col0;
                const float rs = rsv[ai * 4 + m];
                float r[8];
#pragma unroll
                for (int n = 0; n < 2; ++n)
#pragma unroll
                    for (int j = 0; j < 4; ++j) { const float g = acc[ai][0][m][n][j] * rs + bg[n][j], uu = acc[ai][1][m][n][j] * rs + bu[n][j]; r[n * 4 + j] = silu_f(g) * uu; }
                u32x4 w; w.x = pk(r[0], r[1]); w.y = pk(r[2], r[3]); w.z = pk(r[4], r[5]); w.w = pk(r[6], r[7]);
                *(u32x4*)rowp = w; }
    }
};
struct EpiResN {
    static constexpr bool PERM = false;
    float* X; const float* gate; const float* S0; const float* S1; bf16_t* H; const float* gn; const float* scn; float* rssn;
    DI void operator()(const f32x4 (&acc)[2][2][4][2], const pg8::Unit& u, int wr, int wc, int fr, int fq) const {
        const int row0 = u.pm * 256 + wr * 64 + fr, col0 = u.pn * 256 + wc * 32 + 4 * fq;
        const int grp = u.pm < 32 ? 0 : 1 + ((u.pm - 32) >> 2);
        const float* gp = gate + (size_t)grp * 4 * 6144 + col0;
        const bool nxt = H != nullptr;
        f32x4 gv[2][2], cs[2][2];
#pragma unroll
        for (int bj = 0; bj < 2; ++bj)
#pragma unroll
            for (int n = 0; n < 2; ++n) { const int co = bj * 128 + n * 16; gv[bj][n] = *(const f32x4*)(gp + co);
                cs[bj][n] = nxt ? *(const f32x4*)(gn + col0 + co) * (1.f + *(const f32x4*)(scn + (size_t)grp * 4 * 6144 + col0 + co)) : (f32x4){0.f, 0.f, 0.f, 0.f}; }
        const float* sbase = (u.pm < 32 ? S0 + (size_t)row0 * 1024 : S1 + (size_t)(row0 - MC) * 1024) + col0;
        f32x4 xb[2][2][2][2];
#pragma unroll
        for (int r = 0; r < 2; ++r)
#pragma unroll
            for (int bj = 0; bj < 2; ++bj)
#pragma unroll
                for (int n = 0; n < 2; ++n) xb[0][r][bj][n] = *(const f32x4*)(sbase + (size_t)(r * 16) * 1024 + bj * 128 + n * 16);
#pragma unroll
        for (int bt = 0; bt < 4; ++bt) {
            if (bt < 3) {
#pragma unroll
                for (int r = 0; r < 2; ++r) { const int k1 = (bt + 1) * 2 + r, ro1 = (k1 >> 2) * 128 + (k1 & 3) * 16;
#pragma unroll
                    for (int bj = 0; bj < 2; ++bj)
#pragma unroll
                        for (int n = 0; n < 2; ++n) xb[(bt + 1) & 1][r][bj][n] = *(const f32x4*)(sbase + (size_t)ro1 * 1024 + bj * 128 + n * 16); }
            }
#pragma unroll
            for (int r = 0; r < 2; ++r) {
                const int k = bt * 2 + r, ai = k >> 2, m = k & 3, ro = ai * 128 + m * 16;
                float part = 0.f;
                float* xrow = X + (size_t)(row0 + ro) * 1024 + col0; bf16_t* hrow = H + (size_t)(row0 + ro) * 1024 + col0;
#pragma unroll
                for (int bj = 0; bj < 2; ++bj)
#pragma unroll
                    for (int n = 0; n < 2; ++n) { const int co = bj * 128 + n * 16;
                        const f32x4 xn = xb[bt & 1][r][bj][n] + gv[bj][n] * acc[ai][bj][m][n];
                        *(f32x4*)(xrow + co) = xn;
                        if (nxt) { const f32x4 a = xn * cs[bj][n]; u32x2 w; w.x = pk(a[0], a[1]); w.y = pk(a[2], a[3]); *(u32x2*)(hrow + co) = w;
                            part += xn[0] * xn[0] + xn[1] * xn[1] + xn[2] * xn[2] + xn[3] * xn[3]; } }
                if (nxt) { part += __shfl_xor(part, 16); part += __shfl_xor(part, 32);
                    if (fq == 0) __hip_atomic_fetch_add(rssn + row0 + ro, part, __ATOMIC_RELAXED, __HIP_MEMORY_SCOPE_AGENT); }
            }
        }
    }
};

template <class Epi>
DI void run_gemm(char* shm, const bf16_t* A, const bf16_t* Bt, int Mr, int N, int K, int c, const Epi& E, int Gv = 0) {
    pg8::Gemm g{A, Bt, Mr, N, K};
    pg8::StaticOrder S; S.init(Mr, N, Gv ? Gv : (int)gridDim.x, c);
    pg8::gemm_phase<Epi>((LAS unsigned char*)shm, g, S, E);
}

DI void wtile(const P& p, int l, int part, int j, char* shm) {
    int K, N, Np, per, mode = 0; size_t doff; const float* srcp;
    int r = j; const int i = l >> 1; int layer;
    if (part == 1) {
        layer = l;
        if (r < 1408) { K = 1024; N = 5632; Np = 5632; per = 1408; srcp = p.in[13]; doff = W_FFI; mode = 1; }
        else { r -= 1408; K = 2816; N = 1024; Np = 1024; per = 704; srcp = p.in[14]; doff = W_FFO; }
    } else if ((l & 1) == 0) {
        layer = i;
        if (r < 576) { K = 1024; N = 2240; Np = 2304; per = 576; srcp = p.in[15]; doff = W_ABI; }
        else if ((r -= 576) < 256) { K = 1024; N = 1024; Np = 1024; per = 256; srcp = p.in[16]; doff = W_ABO; }
        else if ((r -= 256) < 72) { K = 384; N = 768; Np = 768; per = 72; srcp = p.in[21]; doff = W_QB; }
        else { r -= 72; K = 256; N = 1024; Np = 1024; per = 64; srcp = p.in[23]; doff = W_KVB; }
    } else {
        layer = i;
        if (r < 384) { K = 1024; N = 1536; Np = 1536; per = 384; srcp = p.in[26]; doff = W_GQI; }
        else { r -= 384; K = 1024; N = 1024; Np = 1024; per = 256; srcp = p.in[27]; doff = W_GQO; }
    }
    (void)per;
    const int tt = r, nkt = K / 64, kt = tt % nkt, ntile = tt / nkt;
    const int k0 = kt * 64, n0 = ntile * 64;
    int n0d = n0;
    if (mode == 1) { const int half = n0 >= 2816 ? 1 : 0, f0 = n0 - half * 2816; n0d = (f0 >> 7) * 256 + half * 128 + (f0 & 127); }
    float* tile = (float*)shm;
    const int tid = tid_o();
    {
        const int k = tid >> 3, n8 = (tid & 7) * 8;
        float4 a = make_float4(0.f, 0.f, 0.f, 0.f), b = a;
        if (n0 < N) { const float* s = srcp + (size_t)layer * K * N + (size_t)(k0 + k) * N + n0 + n8;
            const f32x4 va = __builtin_nontemporal_load((const f32x4*)s), vb = __builtin_nontemporal_load((const f32x4*)(s + 4));
            a = make_float4(va[0], va[1], va[2], va[3]); b = make_float4(vb[0], vb[1], vb[2], vb[3]); }
        float* t = tile + k * 65 + n8;
        t[0] = a.x; t[1] = a.y; t[2] = a.z; t[3] = a.w; t[4] = b.x; t[5] = b.y; t[6] = b.z; t[7] = b.w;
    }
    __syncthreads();
    {
        const int n = tid >> 3, k8 = (tid & 7) * 8;
        const float* t = tile + k8 * 65 + n;
        u32x4 w; w.x = pk(t[0], t[65]); w.y = pk(t[130], t[195]); w.z = pk(t[260], t[325]); w.w = pk(t[390], t[455]);
        bf16_t* d = (bf16_t*)(p.ws + doff) + ((size_t)layer * Np + n0d + n) * K + k0 + k8;
        *(u32x4*)d = w;
    }
    __syncthreads();
}

DI void prep_layer(const P& p, int l, int parts, int vb, int nb, char* shm) {
    const int tid = tid_o();
    if (parts & 4) {
        float* scond = (float*)shm;
        float* red = (float*)(shm + 12288);
        if (vb < 96) {
            for (int k = tid; k < 3072; k += NTH) { const int g = k >> 10, d = k & 1023; const float c = g == 0 ? p.in[8][d] : p.in[2][(g - 1) * 1024 + d]; scond[k] = silu_f(c); }
            __syncthreads();
            float* mod = (float*)(p.ws + W_MOD);
            for (int j = vb; j < 96; j += nb) {
                const int e0 = j * 64, c4 = tid & 15, dg = tid >> 4;
                f32x4 a0 = {0.f, 0.f, 0.f, 0.f}, a1 = a0, a2 = a0;
                const float* w = p.in[9] + ((size_t)l * 1024 + dg * 32) * 6144 + e0 + c4 * 4;
#pragma unroll 8
                for (int dd = 0; dd < 32; ++dd) { const f32x4 wv = __builtin_nontemporal_load((const f32x4*)(w + (size_t)dd * 6144)); const int d = dg * 32 + dd;
                    a0 += scond[d] * wv; a1 += scond[1024 + d] * wv; a2 += scond[2048 + d] * wv; }
                *(f32x4*)(red + (dg * 3 + 0) * 64 + c4 * 4) = a0; *(f32x4*)(red + (dg * 3 + 1) * 64 + c4 * 4) = a1; *(f32x4*)(red + (dg * 3 + 2) * 64 + c4 * 4) = a2;
                __syncthreads();
                if (tid < 192) { const int g = tid >> 6, c = tid & 63; float sm = 0.f;
#pragma unroll 8
                    for (int q = 0; q < 32; ++q) sm += red[(q * 3 + g) * 64 + c];
                    mod[(size_t)(g * 4 + l) * 6144 + e0 + c] = sm + p.in[10][l * 6144 + e0 + c]; }
                __syncthreads();
            }
        }
    }
    if (parts & 1) {
        const int nmix = (l & 1) == 0 ? 968 : 640;
        for (int j = vb; j < nmix; j += nb) wtile(p, l, 0, j, shm);
    }
    if (parts & 2) { for (int j = vb; j < 2112; j += nb) wtile(p, l, 1, j, shm); }
}

DI void bias_rows(const P& p, int l, int which, const bf16_t* Wt, int N, float* out, int vw, int nwv) {
    const int lane = tid_o() & 63;
    const float* mod = (const float*)(p.ws + W_MOD);
    float sh[3][16];
#pragma unroll
    for (int g = 0; g < 3; ++g) { const float* sp = mod + (size_t)(g * 4 + l) * 6144 + which * 3072 + lane * 16;
#pragma unroll
        for (int q = 0; q < 4; ++q) { const f32x4 t = *(const f32x4*)(sp + q * 4); sh[g][q * 4] = t[0]; sh[g][q * 4 + 1] = t[1]; sh[g][q * 4 + 2] = t[2]; sh[g][q * 4 + 3] = t[3]; } }
    for (int n0 = vw; n0 < N; n0 += 4 * nwv) {
        u32x4 w0[4], w1[4];
#pragma unroll
        for (int q = 0; q < 4; ++q) { const int n = n0 + q * nwv < N ? n0 + q * nwv : n0;
            w0[q] = *(const u32x4*)(Wt + (size_t)n * 1024 + lane * 16); w1[q] = *(const u32x4*)(Wt + (size_t)n * 1024 + lane * 16 + 8); }
        float a0[4], a1[4], a2[4];
#pragma unroll
        for (int q = 0; q < 4; ++q) {
            const float wv[16] = {bflo(w0[q].x), bfhi(w0[q].x), bflo(w0[q].y), bfhi(w0[q].y), bflo(w0[q].z), bfhi(w0[q].z), bflo(w0[q].w), bfhi(w0[q].w),
                                  bflo(w1[q].x), bfhi(w1[q].x), bflo(w1[q].y), bfhi(w1[q].y), bflo(w1[q].z), bfhi(w1[q].z), bflo(w1[q].w), bfhi(w1[q].w)};
            float t0 = 0.f, t1 = 0.f, t2 = 0.f;
#pragma unroll
            for (int e = 0; e < 16; ++e) { t0 += sh[0][e] * wv[e]; t1 += sh[1][e] * wv[e]; t2 += sh[2][e] * wv[e]; }
            a0[q] = t0; a1[q] = t1; a2[q] = t2;
        }
#pragma unroll
        for (int o = 1; o < 64; o <<= 1) {
#pragma unroll
            for (int q = 0; q < 4; ++q) { a0[q] += __shfl_xor(a0[q], o); a1[q] += __shfl_xor(a1[q], o); a2[q] += __shfl_xor(a2[q], o); } }
        if (lane == 0) {
#pragma unroll
            for (int q = 0; q < 4; ++q) { const int n = n0 + q * nwv; if (n < N) { out[n] = a0[q]; out[N + n] = a1[q]; out[2 * N + n] = a2[q]; } }
        }
    }
}
DI void bias_in(const P& p, int l, int vw, int nwv) {
    const int i = l >> 1; const bool isab = (l & 1) == 0; const int N = isab ? 2304 : 1536;
    const bf16_t* Wt = isab ? (const bf16_t*)(p.ws + W_ABI) + (size_t)i * 2304 * 1024 : (const bf16_t*)(p.ws + W_GQI) + (size_t)i * 1536 * 1024;
    bias_rows(p, l, 0, Wt, N, (float*)(p.ws + W_BIASI) + (size_t)l * 3 * 2304, vw, nwv);
}
DI void bias_ffn(const P& p, int l, int vw, int nwv) {
    bias_rows(p, l, 1, (const bf16_t*)(p.ws + W_FFI) + (size_t)l * 5632 * 1024, 5632, (float*)(p.ws + W_BIASF) + (size_t)l * 3 * 5632, vw, nwv);
}
DI void phase_first(const P& p) {
    const float* gw = p.in[11];
    const float* mod = (const float*)(p.ws + W_MOD);
    bf16_t* H = (bf16_t*)(p.ws + W_H); float* rss = (float*)(p.ws + W_RSS);
    const int tid_ = tid_o(); const int wave = bid_o() * 8 + (tid_ >> 6), nw = gridDim.x * 8, lane = tid_ & 63;
    for (int row = wave; row < M; row += nw) {
        const int grp = row < MC ? 0 : 1 + ((row - MC) >> 10);
        const float* md = mod + (size_t)(grp * 4) * 6144;
        const float* x = row < MC ? p.in[0] + (size_t)row * 1024 : p.in[1] + (size_t)(row - MC) * 1024;
        f32x4 v[4]; float ss = 0.f;
#pragma unroll
        for (int j = 0; j < 4; ++j) { v[j] = __builtin_nontemporal_load((const f32x4*)(x + j * 256 + lane * 4)); ss += v[j][0] * v[j][0] + v[j][1] * v[j][1] + v[j][2] * v[j][2] + v[j][3] * v[j][3]; }
        ss = wave_sum(ss);
        if (lane == 0) rss[row] = ss;
#pragma unroll
        for (int j = 0; j < 4; ++j) { const int c = j * 256 + lane * 4;
            const f32x4 g4 = *(const f32x4*)(gw + c), sc = *(const f32x4*)(md + 1024 + c);
            const f32x4 o = v[j] * g4 * (1.f + sc);
            u32x2 w; w.x = pk(o[0], o[1]); w.y = pk(o[2], o[3]);
            *(u32x2*)(H + (size_t)row * 1024 + c) = w; }
    }
    bias_in(p, 0, wave, nw);
}

DI float log_sigmoid_f(float x) { return fminf(x, 0.f) - __logf(1.f + __expf(-fabsf(x))); }
DI void phase_ab_prep(const P& p, int i) {
    const bf16_t* proj = (const bf16_t*)(p.ws + W_PROJ);
    bf16_t* cqn = (bf16_t*)(p.ws + W_CQN); bf16_t* ckvn = (bf16_t*)(p.ws + W_CKVN); float* la = (float*)(p.ws + W_LA);
    const float* qng = p.in[20] + i * 384; const float* kvg = p.in[22] + i * 256;
    const float* aw2 = p.in[17] + (size_t)i * 2 * 16 * 256; const float* ab = p.in[18] + i * 2 * 256;
    const int tid_ = tid_o(); const int wave = bid_o() * 8 + (tid_ >> 6), nw = gridDim.x * 8, lane = tid_ & 63;
    for (int row = wave; row < MKV; row += nw) {
        if (row >= M) {
            const int cr = row - M, b = cr >> 9, pos = cr & 511;
            const f32x4 v = *(const f32x4*)(p.in[3] + ((size_t)(b * 2 + i) * 512 + pos) * 256 + lane * 4);
            u32x2 w; w.x = pk(v[0], v[1]); w.y = pk(v[2], v[3]);
            *(u32x2*)(ckvn + (size_t)row * 256 + lane * 4) = w;
            continue;
        }
        const bf16_t* pr = proj + (size_t)row * 2304;
        const bool ctx = row < MC; const int b = row >> 8, t = row & 255;
        {
            const unsigned* s = (const unsigned*)(pr + 1568 + lane * 6);
            const unsigned u0 = s[0], u1 = s[1], u2 = s[2];
            float x[6] = {bflo(u0), bfhi(u0), bflo(u1), bfhi(u1), bflo(u2), bfhi(u2)};
            float ss = 0.f;
#pragma unroll
            for (int j = 0; j < 6; ++j) ss += x[j] * x[j];
            ss = wave_sum(ss);
            const float rstd = rsqrtf(ss * (1.f / 384.f) + EPS);
#pragma unroll
            for (int j = 0; j < 6; ++j) x[j] *= rstd * qng[lane * 6 + j];
            unsigned* d = (unsigned*)(cqn + (size_t)row * 384 + lane * 6);
            d[0] = pk(x[0], x[1]); d[1] = pk(x[2], x[3]); d[2] = pk(x[4], x[5]);
        }
        {
            const u32x2 u = *(const u32x2*)(pr + 1952 + lane * 4);
            f32x4 x = {bflo(u.x), bfhi(u.x), bflo(u.y), bfhi(u.y)};
            float ss = wave_sum(x[0] * x[0] + x[1] * x[1] + x[2] * x[2] + x[3] * x[3]);
            const float rstd = rsqrtf(ss * (1.f / 256.f) + EPS);
            x = x * rstd * *(const f32x4*)(kvg + lane * 4);
            u32x2 w; w.x = pk(x[0], x[1]); w.y = pk(x[2], x[3]);
            *(u32x2*)(ckvn + (size_t)row * 256 + lane * 4) = w;
            if (ctx) __builtin_nontemporal_store(x, (f32x4*)(p.out + O_CKV + ((size_t)(b * 2 + i) * 256 + t) * 256 + lane * 4));
        }
        if (ctx && lane < 32) __builtin_nontemporal_store(bf2f(pr[2208 + lane]), p.out + O_KPE + ((size_t)(b * 2 + i) * 256 + t) * 32 + lane);
        {
            const float alo = bf2f(pr[1536 + (lane & 31)]);
#pragma unroll
            for (int z = 0; z < 2; ++z) {
                f32x4 acc = *(const f32x4*)(ab + z * 256 + lane * 4);
#pragma unroll
                for (int r = 0; r < 16; ++r) { const float a = __shfl(alo, z * 16 + r); acc += a * *(const f32x4*)(aw2 + (size_t)(z * 16 + r) * 256 + lane * 4); }
                f32x4 o;
#pragma unroll
                for (int j = 0; j < 4; ++j) o[j] = log_sigmoid_f(acc[j]) * (1.f / 16.f);
                *(f32x4*)(la + ((size_t)z * M + row) * 256 + lane * 4) = o;
            }
        }
    }
}

DI void vt_flush(const bf16_t* vst, int stride, int ncols, int tid, bf16_t* Vt, size_t base, int S, int spos0) {
    __syncthreads();
    if (tid < ncols) { const int hh = tid >> 6, dv = tid & 63; const bf16_t* sp = vst + tid;
        u32x4 o;
        o.x = (unsigned)sp[0] | ((unsigned)sp[stride] << 16); o.y = (unsigned)sp[2 * stride] | ((unsigned)sp[3 * stride] << 16);
        o.z = (unsigned)sp[4 * stride] | ((unsigned)sp[5 * stride] << 16); o.w = (unsigned)sp[6 * stride] | ((unsigned)sp[7 * stride] << 16);
        *(u32x4*)(Vt + base + ((size_t)hh * S) * 64 + (size_t)dv * S + spos0) = o; }
    __syncthreads();
}

constexpr float L2_THETA = 13.287712379549449f;
DI void phase_mla_prep(const P& p, int i, int vb, int nvb, char* shm) {
    const bf16_t* proj = (const bf16_t*)(p.ws + W_PROJ); const bf16_t* qm = (const bf16_t*)(p.ws + W_QM); const bf16_t* kvm = (const bf16_t*)(p.ws + W_KVM);
    bf16_t* Qp = (bf16_t*)(p.ws + W_QP); bf16_t* Kp = (bf16_t*)(p.ws + W_KP); bf16_t* Vt = (bf16_t*)(p.ws + W_VT);
    const float* qng = p.in[24] + i * 96; const float* kng = p.in[25] + i * 96;
    const int tid_ = tid_o(); const int wave = vb * 8 + (tid_ >> 6), nw = nvb * 8, lane = tid_ & 63;
    const int h = lane >> 3, hl = lane & 7, a = hl >> 2, f0 = (hl & 3) * 2;
    const int d1 = 64 + a * 16 + f0, d2 = d1 + 8;
    const float QS = 0.10206207261596577f * LOG2E;
    for (int row = wave; row < MKV; row += nw) {
        const bool is_lat = row >= MC && row < M, is_cache = row >= M;
        int t = 0, lb = 0, cpos = 0;
        if (is_lat) { t = (row - MC) & 1023; lb = (row - MC) >> 10; }
        if (is_cache) { lb = (row - M) >> 9; cpos = (row - M) & 511; }
        float cs[2] = {1.f, 1.f}, sn[2] = {0.f, 0.f};
        if (is_lat) { const float pos = (float)(a == 0 ? (t >> 6) : (t & 63));
#pragma unroll
            for (int e = 0; e < 2; ++e) { const float ang = pos * exp2f(-(float)(f0 + e) * (L2_THETA / 8.f)); cs[e] = __cosf(ang); sn[e] = __sinf(ang); } }
        int rb, S, spos, drow;
        if (is_cache) { rb = MC + lb * 1536; S = 1536; spos = cpos; }
        else if (is_lat) { rb = MC + lb * 1536; S = 1536; spos = 512 + t; }
        else { rb = row & ~255; S = 256; spos = row & 255; }
        drow = rb + spos;
        {
            const bf16_t* kv = kvm + (size_t)row * 1024 + h * 128;
            const u32x4 kn = *(const u32x4*)(kv + hl * 8);
            float x[8] = {bflo(kn.x), bfhi(kn.x), bflo(kn.y), bfhi(kn.y), bflo(kn.z), bfhi(kn.z), bflo(kn.w), bfhi(kn.w)};
            float r1[2], r2[2];
            if (!is_cache) { const bf16_t* kp = proj + (size_t)row * 2304 + 2208; const unsigned u1 = *(const unsigned*)(kp + a * 16 + f0), u2 = *(const unsigned*)(kp + a * 16 + 8 + f0);
                r1[0] = bflo(u1); r1[1] = bfhi(u1); r2[0] = bflo(u2); r2[1] = bfhi(u2); }
            else { const float* kp = p.in[4] + ((size_t)(lb * 2 + i) * 512 + cpos) * 32; r1[0] = kp[a * 16 + f0]; r1[1] = kp[a * 16 + f0 + 1]; r2[0] = kp[a * 16 + 8 + f0]; r2[1] = kp[a * 16 + 8 + f0 + 1]; }
            float ss = r1[0] * r1[0] + r1[1] * r1[1] + r2[0] * r2[0] + r2[1] * r2[1];
#pragma unroll
            for (int j = 0; j < 8; ++j) ss += x[j] * x[j];
            ss += __shfl_xor(ss, 1); ss += __shfl_xor(ss, 2); ss += __shfl_xor(ss, 4);
            const float rstd = rsqrtf(ss * (1.f / 96.f) + EPS);
#pragma unroll
            for (int j = 0; j < 8; ++j) x[j] *= rstd * kng[hl * 8 + j];
            float o1[2], o2[2];
#pragma unroll
            for (int e = 0; e < 2; ++e) { const float y1 = r1[e] * rstd * kng[d1 + e], y2 = r2[e] * rstd * kng[d2 + e]; o1[e] = y1 * cs[e] - y2 * sn[e]; o2[e] = y1 * sn[e] + y2 * cs[e]; }
            bf16_t* kd = Kp + (size_t)drow * 768 + h * 96;
            u32x4 w; w.x = pk(x[0], x[1]); w.y = pk(x[2], x[3]); w.z = pk(x[4], x[5]); w.w = pk(x[6], x[7]);
            *(u32x4*)(kd + hl * 8) = w;
            *(unsigned*)(kd + d1) = pk(o1[0], o1[1]); *(unsigned*)(kd + d2) = pk(o2[0], o2[1]);
            const u32x4 vv = *(const u32x4*)(kv + 64 + hl * 8);
            bf16_t* vst = (bf16_t*)shm; const int wv = tid_ >> 6;
            *(u32x4*)(vst + wv * 520 + h * 64 + hl * 8) = vv;
            vt_flush(vst, 520, 512, tid_, Vt, (size_t)rb * 8 * 64, S, spos - wv);
        }
        if (row < M) {
            const bf16_t* q = qm + (size_t)row * 768 + h * 96;
            const u32x4 qn = *(const u32x4*)(q + hl * 8);
            float x[8] = {bflo(qn.x), bfhi(qn.x), bflo(qn.y), bfhi(qn.y), bflo(qn.z), bfhi(qn.z), bflo(qn.w), bfhi(qn.w)};
            const unsigned u1 = *(const unsigned*)(q + d1), u2 = *(const unsigned*)(q + d2);
            float r1[2] = {bflo(u1), bfhi(u1)}, r2[2] = {bflo(u2), bfhi(u2)};
            float ss = r1[0] * r1[0] + r1[1] * r1[1] + r2[0] * r2[0] + r2[1] * r2[1];
#pragma unroll
            for (int j = 0; j < 8; ++j) ss += x[j] * x[j];
            ss += __shfl_xor(ss, 1); ss += __shfl_xor(ss, 2); ss += __shfl_xor(ss, 4);
            const float rstd = rsqrtf(ss * (1.f / 96.f) + EPS) * QS;
#pragma unroll
            for (int j = 0; j < 8; ++j) x[j] *= rstd * qng[hl * 8 + j];
            float o1[2], o2[2];
#pragma unroll
            for (int e = 0; e < 2; ++e) { const float y1 = r1[e] * rstd * qng[d1 + e], y2 = r2[e] * rstd * qng[d2 + e]; o1[e] = y1 * cs[e] - y2 * sn[e]; o2[e] = y1 * sn[e] + y2 * cs[e]; }
            bf16_t* qd = Qp + (size_t)row * 768 + h * 96;
            u32x4 w; w.x = pk(x[0], x[1]); w.y = pk(x[2], x[3]); w.z = pk(x[4], x[5]); w.w = pk(x[6], x[7]);
            *(u32x4*)(qd + hl * 8) = w;
            *(unsigned*)(qd + d1) = pk(o1[0], o1[1]); *(unsigned*)(qd + d2) = pk(o2[0], o2[1]);
        }
    }
}

DI void phase_gqa_prep(const P& p, int i, char* shm) {
    const bf16_t* proj = (const bf16_t*)(p.ws + W_PROJ);
    bf16_t* Qp = (bf16_t*)(p.ws + W_QP); bf16_t* Kp = (bf16_t*)(p.ws + W_KP); bf16_t* Vt = (bf16_t*)(p.ws + W_VT);
    const float* qng = p.in[28] + i * 64; const float* kng = p.in[29] + i * 64;
    const int tid_ = tid_o(); const int wave = bid_o() * 8 + (tid_ >> 6), nw = gridDim.x * 8, lane = tid_ & 63;
    const int h = lane >> 2, hl = lane & 3, a = hl >> 1, f0 = (hl & 1) * 8;
    const int d1 = a * 32 + f0, d2 = d1 + 16;
    const float QS = 0.125f * LOG2E;
    for (int row = wave; row < MKV; row += nw) {
        if (row >= M) {
            const int cr = row - M, lb = cr >> 9, pos = cr & 511, rb = MC + lb * 1536;
            const size_t so = ((size_t)(lb * 2 + i) * 512 + pos) * 256 + lane * 4;
            const f32x4 kx = *(const f32x4*)(p.in[6] + so), vx = *(const f32x4*)(p.in[7] + so);
            u32x2 w; w.x = pk(kx[0], kx[1]); w.y = pk(kx[2], kx[3]);
            *(u32x2*)(Kp + (size_t)(rb + pos) * 256 + lane * 4) = w;
            bf16_t* vst = (bf16_t*)shm; const int wv = tid_ >> 6;
            u32x2 vw; vw.x = pk(vx[0], vx[1]); vw.y = pk(vx[2], vx[3]);
            *(u32x2*)(vst + wv * 264 + lane * 4) = vw;
            vt_flush(vst, 264, 256, tid_, Vt, (size_t)rb * 4 * 64, 1536, pos - wv);
            continue;
        }
        const bool is_lat = row >= MC;
        int t = 0, lb = 0;
        if (is_lat) { t = (row - MC) & 1023; lb = (row - MC) >> 10; }
        float cs[8], sn[8];
#pragma unroll
        for (int e = 0; e < 8; ++e) { cs[e] = 1.f; sn[e] = 0.f; }
        if (is_lat) { const float pos = (float)(a == 0 ? (t >> 6) : (t & 63));
#pragma unroll
            for (int e = 0; e < 8; ++e) { const float ang = pos * exp2f(-(float)(f0 + e) * (L2_THETA / 16.f)); cs[e] = __cosf(ang); sn[e] = __sinf(ang); } }
        int rb, S, spos;
        if (is_lat) { rb = MC + lb * 1536; S = 1536; spos = 512 + t; } else { rb = row & ~255; S = 256; spos = row & 255; }
        const bf16_t* pr = proj + (size_t)row * 1536;
        {
            const u32x4 ua = *(const u32x4*)(pr + h * 64 + d1), ub = *(const u32x4*)(pr + h * 64 + d2);
            float x1[8] = {bflo(ua.x), bfhi(ua.x), bflo(ua.y), bfhi(ua.y), bflo(ua.z), bfhi(ua.z), bflo(ua.w), bfhi(ua.w)};
            float x2[8] = {bflo(ub.x), bfhi(ub.x), bflo(ub.y), bfhi(ub.y), bflo(ub.z), bfhi(ub.z), bflo(ub.w), bfhi(ub.w)};
            float ss = 0.f;
#pragma unroll
            for (int e = 0; e < 8; ++e) ss += x1[e] * x1[e] + x2[e] * x2[e];
            ss += __shfl_xor(ss, 1); ss += __shfl_xor(ss, 2);
            const float rstd = rsqrtf(ss * (1.f / 64.f) + EPS) * QS;
            float o1[8], o2[8];
#pragma unroll
            for (int e = 0; e < 8; ++e) { const float y1 = x1[e] * rstd * qng[d1 + e], y2 = x2[e] * rstd * qng[d2 + e]; o1[e] = y1 * cs[e] - y2 * sn[e]; o2[e] = y1 * sn[e] + y2 * cs[e]; }
            bf16_t* qd = Qp + (size_t)row * 1024 + h * 64;
            u32x4 w1, w2; w1.x = pk(o1[0], o1[1]); w1.y = pk(o1[2], o1[3]); w1.z = pk(o1[4], o1[5]); w1.w = pk(o1[6], o1[7]);
            w2.x = pk(o2[0], o2[1]); w2.y = pk(o2[2], o2[3]); w2.z = pk(o2[4], o2[5]); w2.w = pk(o2[6], o2[7]);
            *(u32x4*)(qd + d1) = w1; *(u32x4*)(qd + d2) = w2;
        }
        {
            const int hk = h & 3;
            const u32x4 ua = *(const u32x4*)(pr + 1024 + hk * 64 + d1), ub = *(const u32x4*)(pr + 1024 + hk * 64 + d2);
            float x1[8] = {bflo(ua.x), bfhi(ua.x), bflo(ua.y), bfhi(ua.y), bflo(ua.z), bfhi(ua.z), bflo(ua.w), bfhi(ua.w)};
            float x2[8] = {bflo(ub.x), bfhi(ub.x), bflo(ub.y), bfhi(ub.y), bflo(ub.z), bfhi(ub.z), bflo(ub.w), bfhi(ub.w)};
            float ss = 0.f;
#pragma unroll
            for (int e = 0; e < 8; ++e) ss += x1[e] * x1[e] + x2[e] * x2[e];
            ss += __shfl_xor(ss, 1); ss += __shfl_xor(ss, 2);
            const float rstd = rsqrtf(ss * (1.f / 64.f) + EPS);
            float o1[8], o2[8];
#pragma unroll
            for (int e = 0; e < 8; ++e) { const float y1 = x1[e] * rstd * kng[d1 + e], y2 = x2[e] * rstd * kng[d2 + e]; x1[e] = y1; x2[e] = y2; o1[e] = y1 * cs[e] - y2 * sn[e]; o2[e] = y1 * sn[e] + y2 * cs[e]; }
            if (lane < 16) {
                if (!is_lat) { float* kd = p.out + O_K + ((size_t)((row >> 8) * 2 + i) * 256 + (row & 255)) * 256 + hk * 64;
                    __builtin_nontemporal_store((f32x4){x1[0], x1[1], x1[2], x1[3]}, (f32x4*)(kd + d1)); __builtin_nontemporal_store((f32x4){x1[4], x1[5], x1[6], x1[7]}, (f32x4*)(kd + d1 + 4));
                    __builtin_nontemporal_store((f32x4){x2[0], x2[1], x2[2], x2[3]}, (f32x4*)(kd + d2)); __builtin_nontemporal_store((f32x4){x2[4], x2[5], x2[6], x2[7]}, (f32x4*)(kd + d2 + 4)); }
                bf16_t* kd = Kp + (size_t)(rb + spos) * 256 + hk * 64;
                u32x4 w1, w2; w1.x = pk(o1[0], o1[1]); w1.y = pk(o1[2], o1[3]); w1.z = pk(o1[4], o1[5]); w1.w = pk(o1[6], o1[7]);
                w2.x = pk(o2[0], o2[1]); w2.y = pk(o2[2], o2[3]); w2.z = pk(o2[4], o2[5]); w2.w = pk(o2[6], o2[7]);
                *(u32x4*)(kd + d1) = w1; *(u32x4*)(kd + d2) = w2;
            }
        }
        {
            const u32x2 u = *(const u32x2*)(pr + 1280 + lane * 4);
            if (!is_lat) __builtin_nontemporal_store((f32x4){bflo(u.x), bfhi(u.x), bflo(u.y), bfhi(u.y)}, (f32x4*)(p.out + O_V + ((size_t)((row >> 8) * 2 + i) * 256 + (row & 255)) * 256 + lane * 4));
            bf16_t* vst = (bf16_t*)shm; const int wv = tid_ >> 6;
            *(u32x2*)(vst + wv * 264 + lane * 4) = u;
            vt_flush(vst, 264, 256, tid_, Vt, (size_t)rb * 4 * 64, S, spos - wv);
        }
    }
}

template <int DQK, int HQ, int HKV, int COLOFF>
DI void phase_attn(const P& p) {
    constexpr int NK = DQK / 32, KS = HKV * DQK, QSTR = HQ * DQK;
    const bf16_t* Qp = (const bf16_t*)(p.ws + W_QP); const bf16_t* Kp = (const bf16_t*)(p.ws + W_KP); const bf16_t* Vt = (const bf16_t*)(p.ws + W_VT);
    bf16_t* mix = (bf16_t*)(p.ws + W_MIX);
    const int tid_ = tid_o(); const int wave = bid_o() * 8 + (tid_ >> 6), nw = gridDim.x * 8, lane = tid_ & 63, fr = lane & 15, fq = lane >> 4;
    constexpr int NQT = M / 16;
    for (int it = wave; it < NQT * HQ; it += nw) {
        const int qt = NQT - 1 - it / HQ, h = it % HQ, row0 = qt * 16;
        int rb, S;
        if (row0 < MC) { rb = row0 & ~255; S = 256; } else { rb = MC + ((row0 - MC) >> 10) * 1536; S = 1536; }
        const int hk = h / (HQ / HKV);
        const bf16_t* Kb = Kp + (size_t)rb * KS + hk * DQK + (size_t)fr * KS + fq * 8;
        const bf16_t* Vb = Vt + ((size_t)rb * HKV + (size_t)hk * S) * 64 + (size_t)fr * S + fq * 4;
        bf16x8 qf[NK];
#pragma unroll
        for (int ks = 0; ks < NK; ++ks) qf[ks] = *(const bf16x8*)(Qp + (size_t)(row0 + fr) * QSTR + h * DQK + ks * 32 + fq * 8);
        f32x4 o[4];
#pragma unroll
        for (int tq = 0; tq < 4; ++tq) o[tq] = (f32x4){0.f, 0.f, 0.f, 0.f};
        float mrun = -1e30f, lsum = 0.f;
        for (int k0 = 0; k0 < S; k0 += 32) {
            f32x4 s0 = {0.f, 0.f, 0.f, 0.f}, s1 = s0;
#pragma unroll
            for (int ks = 0; ks < NK; ++ks) {
                const bf16x8 ka = *(const bf16x8*)(Kb + (size_t)k0 * KS + ks * 32), kb2 = *(const bf16x8*)(Kb + (size_t)(k0 + 16) * KS + ks * 32);
                s0 = mfma16(ka, qf[ks], s0); s1 = mfma16(kb2, qf[ks], s1);
            }
            s16x4 va[4], vb[4];
#pragma unroll
            for (int tq = 0; tq < 4; ++tq) { va[tq] = *(const s16x4*)(Vb + (size_t)(tq * 16) * S + k0); vb[tq] = *(const s16x4*)(Vb + (size_t)(tq * 16) * S + k0 + 16); }
            float mx = fmaxf(fmaxf(fmaxf(s0[0], s0[1]), fmaxf(s0[2], s0[3])), fmaxf(fmaxf(s1[0], s1[1]), fmaxf(s1[2], s1[3])));
            mx = fmaxf(mx, __shfl_xor(mx, 16)); mx = fmaxf(mx, __shfl_xor(mx, 32));
            const float mn = fmaxf(mrun, mx), alpha = exp2f(mrun - mn); mrun = mn;
            float p0[4], p1[4], ps = 0.f;
#pragma unroll
            for (int j = 0; j < 4; ++j) { p0[j] = exp2f(s0[j] - mn); p1[j] = exp2f(s1[j] - mn); ps += p0[j] + p1[j]; }
            lsum = lsum * alpha + ps;
            u32x4 pw; pw.x = pk(p0[0], p0[1]); pw.y = pk(p0[2], p0[3]); pw.z = pk(p1[0], p1[1]); pw.w = pk(p1[2], p1[3]);
            const bf16x8 pf = __builtin_bit_cast(bf16x8, pw);
#pragma unroll
            for (int tq = 0; tq < 4; ++tq) {
                const bf16x8 vf = __builtin_shufflevector(va[tq], vb[tq], 0, 1, 2, 3, 4, 5, 6, 7);
                o[tq] = mfma16(vf, pf, o[tq] * alpha);
            }
        }
        lsum += __shfl_xor(lsum, 16); lsum += __shfl_xor(lsum, 32);
        const float inv = 1.f / lsum;
        bf16_t* od = mix + (size_t)(row0 + fr) * 1024 + COLOFF + h * 64 + fq * 4;
#pragma unroll
        for (int tq = 0; tq < 4; ++tq) { u32x2 w; w.x = pk(o[tq][0] * inv, o[tq][1] * inv); w.y = pk(o[tq][2] * inv, o[tq][3] * inv); *(u32x2*)(od + tq * 16) = w; }
    }
}


template <int DQK, int HQ, int HKV, int COLOFF>
DI void phase_attn2(const P& p, char* shm, int bshift) {
    constexpr int NK = DQK / 32, KS = HKV * DQK, QSTR = HQ * DQK, GQ = HQ / HKV, RB = (8 / GQ) * 32;
    constexpr int KROW = DQK * 2 + 16, VROW = 144, KBUF = 64 * KROW, VBUF = 64 * VROW, KCH = DQK / 8, NKCH = 64 * KCH;
    constexpr int NL = 2 * HKV * (1024 / RB), NC = 32 * HKV * (256 / RB);
    const bf16_t* Qp = (const bf16_t*)(p.ws + W_QP); const bf16_t* Kp = (const bf16_t*)(p.ws + W_KP); const bf16_t* Vt = (const bf16_t*)(p.ws + W_VT);
    bf16_t* mix = (bf16_t*)(p.ws + W_MIX);
    const int tid = tid_o(), w = tid >> 6, lane = tid & 63, fr = lane & 15, fq = lane >> 4;
    const int G = gridDim.x, vb = (bid_o() + bshift) % G;
    for (int kit = 0;; ++kit) {
        int item;
        if (G > NL) { if (vb < NL) { if (kit > 0) break; item = vb; } else { const int c = (vb - NL) + kit * (G - NL); if (c >= NC) break; item = NL + c; } }
        else { item = vb + kit * G; if (item >= NL + NC) break; }
        int rb, S, qrow0, hk;
        if (item < NL) { constexpr int QB = 1024 / RB; const int lb = item / (HKV * QB), rem = item % (HKV * QB); hk = rem / QB; rb = MC + lb * 1536; S = 1536; qrow0 = MC + lb * 1024 + (rem % QB) * RB; }
        else { constexpr int QB = 256 / RB; const int c = item - NL, b = c / (HKV * QB), rem = c % (HKV * QB); hk = rem / QB; rb = b * 256; S = 256; qrow0 = b * 256 + (rem % QB) * RB; }
        const int hq = hk * GQ + (w % GQ), q0 = qrow0 + (w / GQ) * 32;
        bf16x8 qf[2][NK];
#pragma unroll
        for (int qi = 0; qi < 2; ++qi)
#pragma unroll
            for (int ks = 0; ks < NK; ++ks) qf[qi][ks] = *(const bf16x8*)(Qp + (size_t)(q0 + qi * 16 + fr) * QSTR + hq * DQK + ks * 32 + fq * 8);
        f32x4 o[4][2];
#pragma unroll
        for (int tq = 0; tq < 4; ++tq) { o[tq][0] = (f32x4){0.f, 0.f, 0.f, 0.f}; o[tq][1] = o[tq][0]; }
        float mrun[2] = {-1e30f, -1e30f}, lsum[2] = {0.f, 0.f};
        const int kr0 = tid / KCH, kc0 = tid % KCH, kr1 = (tid + 512) / KCH, kc1 = (tid + 512) % KCH;
        const bool has1 = (tid + 512) < NKCH;
        const bf16_t* kg0 = Kp + (size_t)(rb + kr0) * KS + hk * DQK + kc0 * 8;
        const bf16_t* kg1 = Kp + (size_t)(rb + (has1 ? kr1 : 0)) * KS + hk * DQK + kc1 * 8;
        const int kl0 = kr0 * KROW + kc0 * 16, kl1 = kr1 * KROW + kc1 * 16;
        const int vr = tid >> 3, vc = tid & 7;
        const bf16_t* vg = Vt + ((size_t)rb * HKV + (size_t)hk * S) * 64 + (size_t)vr * S + vc * 8;
        const int vl = 2 * KBUF + vr * VROW + vc * 16;
        const int nseg = S / 256;
        u32x4 ks0, ks1 = {0u, 0u, 0u, 0u}, vs;
        for (int seg = 0; seg < nseg; ++seg) {
        const bf16_t* kg0s = kg0 + (size_t)seg * 256 * KS; const bf16_t* kg1s = kg1 + (size_t)seg * 256 * KS; const bf16_t* vgs = vg + seg * 256;
        ks0 = *(const u32x4*)kg0s; if (has1) ks1 = *(const u32x4*)kg1s; vs = *(const u32x4*)vgs;
        *(u32x4*)(shm + kl0) = ks0; if (has1) *(u32x4*)(shm + kl1) = ks1; *(u32x4*)(shm + vl) = vs;
        __syncthreads();
#pragma unroll 1
        for (int t = 0; t < 4; ++t) {
            const int cur = t & 1;
            if (t + 1 < 4) { const size_t ko = (size_t)(t + 1) * 64 * KS; ks0 = *(const u32x4*)(kg0s + ko); if (has1) ks1 = *(const u32x4*)(kg1s + ko); vs = *(const u32x4*)(vgs + (t + 1) * 64); }
            const char* kb = shm + cur * KBUF; const char* vbp = shm + 2 * KBUF + cur * VBUF;
            f32x4 s[4][2];
#pragma unroll
            for (int kt = 0; kt < 4; ++kt) {
                bf16x8 kf[NK];
#pragma unroll
                for (int ks = 0; ks < NK; ++ks) kf[ks] = *(const bf16x8*)(kb + (kt * 16 + fr) * KROW + ks * 64 + fq * 16);
#pragma unroll
                for (int qi = 0; qi < 2; ++qi) { f32x4 a = {0.f, 0.f, 0.f, 0.f};
#pragma unroll
                    for (int ks = 0; ks < NK; ++ks) a = mfma16(kf[ks], qf[qi][ks], a);
                    s[kt][qi] = a; }
            }
            bf16x8 pf[2][2];
#pragma unroll
            for (int qi = 0; qi < 2; ++qi) {
                float mx = -1e30f;
#pragma unroll
                for (int kt = 0; kt < 4; ++kt) mx = fmaxf(mx, fmaxf(fmaxf(s[kt][qi][0], s[kt][qi][1]), fmaxf(s[kt][qi][2], s[kt][qi][3])));
                mx = fmaxf(mx, __shfl_xor(mx, 16)); mx = fmaxf(mx, __shfl_xor(mx, 32));
                const float mn = fmaxf(mrun[qi], mx), alpha = __builtin_amdgcn_exp2f(mrun[qi] - mn); mrun[qi] = mn;
                float ps = 0.f;
#pragma unroll
                for (int kt = 0; kt < 4; ++kt)
#pragma unroll
                    for (int r = 0; r < 4; ++r) { const float e = __builtin_amdgcn_exp2f(s[kt][qi][r] - mn); s[kt][qi][r] = e; ps += e; }
                lsum[qi] = lsum[qi] * alpha + ps;
#pragma unroll
                for (int kk = 0; kk < 2; ++kk) { u32x4 pw; pw.x = pk(s[2 * kk][qi][0], s[2 * kk][qi][1]); pw.y = pk(s[2 * kk][qi][2], s[2 * kk][qi][3]);
                    pw.z = pk(s[2 * kk + 1][qi][0], s[2 * kk + 1][qi][1]); pw.w = pk(s[2 * kk + 1][qi][2], s[2 * kk + 1][qi][3]); pf[qi][kk] = __builtin_bit_cast(bf16x8, pw); }
#pragma unroll
                for (int tq = 0; tq < 4; ++tq) o[tq][qi] = o[tq][qi] * alpha;
            }
#pragma unroll
            for (int tq = 0; tq < 4; ++tq)
#pragma unroll
                for (int kk = 0; kk < 2; ++kk) {
                    const s16x4 va = *(const s16x4*)(vbp + (tq * 16 + fr) * VROW + kk * 64 + fq * 8), vb2 = *(const s16x4*)(vbp + (tq * 16 + fr) * VROW + kk * 64 + 32 + fq * 8);
                    const bf16x8 vf = __builtin_shufflevector(va, vb2, 0, 1, 2, 3, 4, 5, 6, 7);
                    o[tq][0] = mfma16(vf, pf[0][kk], o[tq][0]); o[tq][1] = mfma16(vf, pf[1][kk], o[tq][1]);
                }
            if (t + 1 < 4) { const int nb = cur ^ 1; *(u32x4*)(shm + nb * KBUF + kl0) = ks0; if (has1) *(u32x4*)(shm + nb * KBUF + kl1) = ks1; *(u32x4*)(shm + nb * VBUF + vl) = vs; }
            __syncthreads();
        }
        }
#pragma unroll
        for (int qi = 0; qi < 2; ++qi) {
            float l = lsum[qi]; l += __shfl_xor(l, 16); l += __shfl_xor(l, 32);
            const float inv = 1.f / l;
            bf16_t* od = mix + (size_t)(q0 + qi * 16 + fr) * 1024 + COLOFF + hq * 64 + fq * 4;
#pragma unroll
            for (int tq = 0; tq < 4; ++tq) { u32x2 wv; wv.x = pk(o[tq][qi][0] * inv, o[tq][qi][1] * inv); wv.y = pk(o[tq][qi][2] * inv, o[tq][qi][3] * inv); *(u32x2*)(od + tq * 16) = wv; }
        }
    }
}

DI void phase_gla(const P& p, int i, char* shm, int part) {
    float* bL = (float*)shm;
    bf16_t* qloc = (bf16_t*)(shm + 16640);
    bf16_t* kloc = qloc + 64 * 72;
    bf16_t* qin = kloc + 64 * 72;
    bf16_t* kstT = qin + 64 * 72;
    bf16_t* Am = kstT + 64 * 72;
    bf16_t* vT = Am + 64 * 72;
    float* segs = (float*)(vT + 128 * 72);
    const bf16_t* proj = (const bf16_t*)(p.ws + W_PROJ); const float* la = (const float*)(p.ws + W_LA); float* odir = (float*)(p.ws + W_ODIR);
    const int tid = tid_o(), w = tid >> 6, lane = tid & 63, fr = lane & 15, fq = lane >> 4;
    const int G = gridDim.x;
    const bool split = (G == 256);
    float* gst = (float*)(p.ws + W_GST);
    if (part < 2 && !split) return;
    const int nrounds = part < 2 ? 1 : ((G == 256) ? 2 : (272 + G - 1) / G);
    for (int rnd = 0; rnd < nrounds; ++rnd) {
        int j;
        const int bidg = bid_o();
        if (part < 2) j = bidg < 16 ? bidg : -1;
        else if (G == 256) {
            if (rnd == 0) j = (bidg >= 128 && bidg < 192) ? -1 : bidg;
            else j = (bidg >= 16 && bidg < 32) ? 240 + bidg : ((bidg >= 96 && bidg < 128) ? bidg + 32 : ((bidg >= 32 && bidg < 64) ? bidg + 128 : -1));
        }
        else j = bidg + rnd * G;
        if (j < 0 || j >= 272) continue;
        int b, hd, dir, T, rowbase; bool ctx;
        if (j < 16) { ctx = false; b = j >> 3; hd = (j >> 1) & 3; dir = j & 1; T = 1024; rowbase = MC + b * 1024; }
        else { const int jj = j - 16; ctx = true; b = jj >> 3; hd = (jj >> 1) & 3; dir = jj & 1; T = 256; rowbase = b * 256; }
        f32x4 Sacc[4];
        const size_t sidx = ((size_t)((b * 2 + i) * 2 + dir) * 4 + hd) * 64 * 128;
#pragma unroll
        for (int dt = 0; dt < 4; ++dt) {
            if (ctx) Sacc[dt] = (f32x4){0.f, 0.f, 0.f, 0.f};
            else if (split && part > 0) Sacc[dt] = *(const f32x4*)(gst + ((size_t)j * 512 + tid) * 16 + dt * 4);
            else {
#pragma unroll
                for (int r = 0; r < 4; ++r) Sacc[dt][r] = p.in[5][sidx + (size_t)(dt * 16 + fq * 4 + r) * 128 + w * 16 + fr];
            }
        }
        const int nch = T / 64;
        const int c0 = (!ctx && split) ? (part == 0 ? 0 : (part == 1 ? 5 : 8)) : 0;
        const int c1 = (!ctx && split) ? (part == 0 ? 5 : (part == 1 ? 8 : 16)) : nch;
        const int ii = tid & 63, d8 = (tid >> 6) * 8, v16 = (tid >> 6) * 16;
        f32x4 nl0, nl1; u32x4 nqu, nku, nv0, nv1;
        {
            const int trow0 = dir == 0 ? c0 * 64 + ii : T - 1 - (c0 * 64 + ii); const size_t g0 = (size_t)rowbase + trow0;
            const float* lp = la + ((size_t)dir * M + g0) * 256 + hd * 64 + d8; nl0 = *(const f32x4*)lp; nl1 = *(const f32x4*)(lp + 4);
            const bf16_t* pr = proj + g0 * 2304 + hd * 64 + d8; nqu = *(const u32x4*)pr; nku = *(const u32x4*)(pr + 256);
            const bf16_t* pv = proj + g0 * 2304 + 512 + hd * 128 + v16; nv0 = *(const u32x4*)pv; nv1 = *(const u32x4*)(pv + 8);
        }
        for (int c = c0; c < c1; ++c) {
            const f32x4 l0 = nl0, l1 = nl1; const u32x4 qu = nqu, ku = nku, v0 = nv0, v1 = nv1;
            {
                float* bd = bL + ii * 65 + d8;
                bd[0] = l0[0]; bd[1] = l0[1]; bd[2] = l0[2]; bd[3] = l0[3]; bd[4] = l1[0]; bd[5] = l1[1]; bd[6] = l1[2]; bd[7] = l1[3];
            }
            if (c + 1 < c1) {
                const int trn = dir == 0 ? (c + 1) * 64 + ii : T - 1 - ((c + 1) * 64 + ii); const size_t gn = (size_t)rowbase + trn;
                const float* lp = la + ((size_t)dir * M + gn) * 256 + hd * 64 + d8; nl0 = *(const f32x4*)lp; nl1 = *(const f32x4*)(lp + 4);
                const bf16_t* pr = proj + gn * 2304 + hd * 64 + d8; nqu = *(const u32x4*)pr; nku = *(const u32x4*)(pr + 256);
                const bf16_t* pv = proj + gn * 2304 + 512 + hd * 128 + v16; nv0 = *(const u32x4*)pv; nv1 = *(const u32x4*)(pv + 8);
            }
            __syncthreads();
            {
                const int d = tid & 63, seg = tid >> 6;
                float loc[8]; float acc = 0.f;
#pragma unroll
                for (int r = 0; r < 8; ++r) { acc += bL[(seg * 8 + r) * 65 + d]; loc[r] = acc; }
                segs[seg * 64 + d] = acc;
                __syncthreads();
                float pre = 0.f;
#pragma unroll
                for (int s = 0; s < 8; ++s) pre += (s < seg) ? segs[s * 64 + d] : 0.f;
#pragma unroll
                for (int r = 0; r < 8; ++r) bL[(seg * 8 + r) * 65 + d] = pre + loc[r];
            }
            __syncthreads();
            {
                float qv[8] = {bflo(qu.x), bfhi(qu.x), bflo(qu.y), bfhi(qu.y), bflo(qu.z), bfhi(qu.z), bflo(qu.w), bfhi(qu.w)};
                float kv[8] = {bflo(ku.x), bfhi(ku.x), bflo(ku.y), bfhi(ku.y), bflo(ku.z), bfhi(ku.z), bflo(ku.w), bfhi(ku.w)};
                float ql[8], kl[8], qi[8];
#pragma unroll
                for (int e = 0; e < 8; ++e) {
                    const float bb = bL[ii * 65 + d8 + e], bref = bL[31 * 65 + d8 + e], blast = bL[63 * 65 + d8 + e];
                    const float q = qv[e] * 0.125f, k = kv[e];
                    ql[e] = q * __expf(bb - bref); kl[e] = k * __expf(bref - bb); qi[e] = q * __expf(bb);
                    kstT[(d8 + e) * 72 + ii] = f2bf(k * __expf(blast - bb));
                }
                u32x4 wq, wk, wi;
                wq.x = pk(ql[0], ql[1]); wq.y = pk(ql[2], ql[3]); wq.z = pk(ql[4], ql[5]); wq.w = pk(ql[6], ql[7]);
                wk.x = pk(kl[0], kl[1]); wk.y = pk(kl[2], kl[3]); wk.z = pk(kl[4], kl[5]); wk.w = pk(kl[6], kl[7]);
                wi.x = pk(qi[0], qi[1]); wi.y = pk(qi[2], qi[3]); wi.z = pk(qi[4], qi[5]); wi.w = pk(qi[6], qi[7]);
                *(u32x4*)(qloc + ii * 72 + d8) = wq; *(u32x4*)(kloc + ii * 72 + d8) = wk; *(u32x4*)(qin + ii * 72 + d8) = wi;
                bf16_t* vd = vT + v16 * 72 + ii;
                vd[0 * 72] = (bf16_t)(v0.x & 0xffff); vd[1 * 72] = (bf16_t)(v0.x >> 16); vd[2 * 72] = (bf16_t)(v0.y & 0xffff); vd[3 * 72] = (bf16_t)(v0.y >> 16);
                vd[4 * 72] = (bf16_t)(v0.z & 0xffff); vd[5 * 72] = (bf16_t)(v0.z >> 16); vd[6 * 72] = (bf16_t)(v0.w & 0xffff); vd[7 * 72] = (bf16_t)(v0.w >> 16);
                vd[8 * 72] = (bf16_t)(v1.x & 0xffff); vd[9 * 72] = (bf16_t)(v1.x >> 16); vd[10 * 72] = (bf16_t)(v1.y & 0xffff); vd[11 * 72] = (bf16_t)(v1.y >> 16);
                vd[12 * 72] = (bf16_t)(v1.z & 0xffff); vd[13 * 72] = (bf16_t)(v1.z >> 16); vd[14 * 72] = (bf16_t)(v1.w & 0xffff); vd[15 * 72] = (bf16_t)(v1.w >> 16);
            }
            __syncthreads();
            {
                const int it = w >> 1;
#pragma unroll
                for (int u = 0; u < 2; ++u) {
                    const int st = (w & 1) * 2 + u;
                    f32x4 a = {0.f, 0.f, 0.f, 0.f};
                    if (st <= it) {
#pragma unroll
                        for (int ks = 0; ks < 2; ++ks) {
                            const bf16x8 aq = *(const bf16x8*)(qloc + (it * 16 + fr) * 72 + ks * 32 + fq * 8);
                            const bf16x8 bk = *(const bf16x8*)(kloc + (st * 16 + fr) * 72 + ks * 32 + fq * 8);
                            a = mfma16(aq, bk, a);
                        }
                    }
#pragma unroll
                    for (int r = 0; r < 4; ++r) { const int irow = it * 16 + fq * 4 + r, s = st * 16 + fr; Am[irow * 72 + s] = f2bf(s <= irow ? a[r] : 0.f); }
                }
            }
            __syncthreads();
            {
                bf16x8 vf[2], sb[2];
#pragma unroll
                for (int ks = 0; ks < 2; ++ks) {
                    vf[ks] = *(const bf16x8*)(vT + (w * 16 + fr) * 72 + ks * 32 + fq * 8);
                    u32x4 sw; sw.x = pk(Sacc[2 * ks][0], Sacc[2 * ks][1]); sw.y = pk(Sacc[2 * ks][2], Sacc[2 * ks][3]);
                    sw.z = pk(Sacc[2 * ks + 1][0], Sacc[2 * ks + 1][1]); sw.w = pk(Sacc[2 * ks + 1][2], Sacc[2 * ks + 1][3]);
                    sb[ks] = __builtin_bit_cast(bf16x8, sw);
                }
#pragma unroll
                for (int it = 0; it < 4; ++it) {
                    f32x4 o = {0.f, 0.f, 0.f, 0.f};
#pragma unroll
                    for (int ks = 0; ks < 2; ++ks) {
                        const bf16x8 aa = *(const bf16x8*)(Am + (it * 16 + fr) * 72 + ks * 32 + fq * 8);
                        o = mfma16(aa, vf[ks], o);
                        const s16x4 q0 = *(const s16x4*)(qin + (it * 16 + fr) * 72 + ks * 32 + fq * 4), q1 = *(const s16x4*)(qin + (it * 16 + fr) * 72 + ks * 32 + 16 + fq * 4);
                        const bf16x8 aq = __builtin_shufflevector(q0, q1, 0, 1, 2, 3, 4, 5, 6, 7);
                        o = mfma16(aq, sb[ks], o);
                    }
#pragma unroll
                    for (int r = 0; r < 4; ++r) { const int iloc = c * 64 + it * 16 + fq * 4 + r; const int tr = dir == 0 ? iloc : T - 1 - iloc;
                        odir[((size_t)dir * M + rowbase + tr) * 512 + hd * 128 + w * 16 + fr] = o[r]; }
                }
#pragma unroll
                for (int dt = 0; dt < 4; ++dt) {
                    f32x4 acc;
#pragma unroll
                    for (int r = 0; r < 4; ++r) acc[r] = Sacc[dt][r] * __expf(bL[63 * 65 + dt * 16 + fq * 4 + r]);
#pragma unroll
                    for (int ks = 0; ks < 2; ++ks) { const bf16x8 ak = *(const bf16x8*)(kstT + (dt * 16 + fr) * 72 + ks * 32 + fq * 8); acc = mfma16(ak, vf[ks], acc); }
                    Sacc[dt] = acc;
                }
            }
            __syncthreads();
        }
        if (!ctx && split && part < 2) {
#pragma unroll
            for (int dt = 0; dt < 4; ++dt) *(f32x4*)(gst + ((size_t)j * 512 + tid) * 16 + dt * 4) = Sacc[dt];
        }
        if (ctx) {
#pragma unroll
            for (int dt = 0; dt < 4; ++dt)
#pragma unroll
                for (int r = 0; r < 4; ++r) __builtin_nontemporal_store(Sacc[dt][r], p.out + O_GLA + sidx + (size_t)(dt * 16 + fq * 4 + r) * 128 + w * 16 + fr);
        }
    }
}

DI void phase_gla_finish(const P& p, int i) {
    const bf16_t* proj = (const bf16_t*)(p.ws + W_PROJ); const float* odir = (const float*)(p.ws + W_ODIR); bf16_t* mix = (bf16_t*)(p.ws + W_MIX);
    const float* og = p.in[19] + i * 128;
    const int tid_ = tid_o(); const int wave = bid_o() * 8 + (tid_ >> 6), nw = gridDim.x * 8, lane = tid_ & 63;
    for (int row = wave; row < M; row += nw) {
        const float* of = odir + (size_t)row * 512 + lane * 8; const float* ob = of + (size_t)M * 512;
        const f32x4 a0 = __builtin_nontemporal_load((const f32x4*)of) + __builtin_nontemporal_load((const f32x4*)ob), a1 = __builtin_nontemporal_load((const f32x4*)(of + 4)) + __builtin_nontemporal_load((const f32x4*)(ob + 4));
        float x[8] = {a0[0], a0[1], a0[2], a0[3], a1[0], a1[1], a1[2], a1[3]};
        float ss = 0.f;
#pragma unroll
        for (int e = 0; e < 8; ++e) ss += x[e] * x[e];
        ss += __shfl_xor(ss, 1); ss += __shfl_xor(ss, 2); ss += __shfl_xor(ss, 4); ss += __shfl_xor(ss, 8);
        const float rstd = rsqrtf(ss * (1.f / 128.f) + EPS);
        const u32x4 ru = *(const u32x4*)(proj + (size_t)row * 2304 + 1024 + lane * 8);
        float rv[8] = {bflo(ru.x), bfhi(ru.x), bflo(ru.y), bfhi(ru.y), bflo(ru.z), bfhi(ru.z), bflo(ru.w), bfhi(ru.w)};
        const int gc = (lane & 15) * 8;
#pragma unroll
        for (int e = 0; e < 8; ++e) x[e] = x[e] * rstd * og[gc + e] * silu_f(rv[e]);
        u32x4 w; w.x = pk(x[0], x[1]); w.y = pk(x[2], x[3]); w.z = pk(x[4], x[5]); w.w = pk(x[6], x[7]);
        *(u32x4*)(mix + (size_t)row * 1024 + lane * 8) = w;
    }
}

constexpr int NPHASE = 2 + 9 + 6 + 9 + 6;

DI void run_phase(const P& p, int ph, char* shm) {
    const int bid = bid_o(); const int G = (int)gridDim.x;
    char* ws = p.ws;
    if (ph == 0) {
        {   float* rss = (float*)(ws + W_RSS) + M; const int tid = tid_o();
            for (int k = bid * NTH + tid; k < 7 * M; k += G * NTH) rss[k] = 0.f; }
        if (G == 256) { if (bid < 96) prep_layer(p, 0, 4, bid, 96, shm); else prep_layer(p, 0, 1, bid - 96, 160, shm); }
        else prep_layer(p, 0, 7, bid, G, shm);
        if (G != 256) { for (int ll = 1; ll < 4; ++ll) prep_layer(p, ll, 7, bid, G, shm); }
        return; }
    if (ph == 1) { phase_first(p); return; }
    int l, s; { const int q = ph - 2; if (q < 9) { l = 0; s = q; } else if (q < 15) { l = 1; s = q - 9; } else if (q < 24) { l = 2; s = q - 15; } else { l = 3; s = q - 24; } }
    const int i = l >> 1; const bool isab = (l & 1) == 0;
    enum { OP_INPROJ, OP_ABPREP, OP_MLAGEMM, OP_MLAPREP, OP_GLAATTN, OP_GLAFIN, OP_OUTPROJ, OP_FFNIN, OP_FFNOUT, OP_GQAPREP, OP_GQAATTN };
    int op;
    if (isab) {
        switch (s) { case 0: op = OP_INPROJ; break; case 1: op = OP_ABPREP; break; case 2: op = OP_MLAGEMM; break; case 3: op = OP_MLAPREP; break;
            case 4: op = OP_GLAATTN; break; case 5: op = OP_GLAFIN; break; case 6: op = OP_OUTPROJ; break; case 7: op = OP_FFNIN; break; default: op = OP_FFNOUT; break; }
    } else {
        switch (s) { case 0: op = OP_INPROJ; break; case 1: op = OP_GQAPREP; break; case 2: op = OP_GQAATTN; break; case 3: op = OP_OUTPROJ; break;
            case 4: op = OP_FFNIN; break; default: op = OP_FFNOUT; break; }
    }
    const float* rssb = (const float*)(ws + W_RSS);
    switch (op) {
    case OP_ABPREP: phase_ab_prep(p, i); break;
    case OP_MLAPREP: if (G == 256) { if (bid < 16) phase_gla(p, i, shm, 1); else phase_mla_prep(p, i, bid - 16, 240, shm); } else phase_mla_prep(p, i, bid, G, shm); break;
    case OP_GQAPREP: phase_gqa_prep(p, i, shm); break;
    case OP_GLAATTN: phase_gla(p, i, shm, 2); phase_attn2<96, 8, 8, 512>(p, shm, 128); break;
    case OP_GQAATTN: phase_attn2<64, 16, 4, 0>(p, shm, 0); break;
    case OP_GLAFIN: phase_gla_finish(p, i); break;
    case OP_INPROJ: {
        EpiBfN E; E.O = (bf16_t*)(ws + W_PROJ); E.rss = rssb + (size_t)(2 * l) * M; E.bias = (const float*)(ws + W_BIASI) + (size_t)l * 3 * 2304;
        const bf16_t* Bt; int N;
        if (isab) { Bt = (const bf16_t*)(ws + W_ABI) + (size_t)i * 2304 * 1024; N = 2304; } else { Bt = (const bf16_t*)(ws + W_GQI) + (size_t)i * 1536 * 1024; N = 1536; }
        E.ldc = N; E.gs = N;
        run_gemm<EpiBfN>(shm, (const bf16_t*)(ws + W_H), Bt, M, N, 1024, bid, E);
        if (l == 0 && bid >= 104 && G == 256) prep_layer(p, 0, 2, bid - 104, 152, shm);
        else if (l == 0 && G != 256) prep_layer(p, 0, 0, bid, G, shm);
    } break;
    case OP_MLAGEMM: {
        if (G == 256 && bid < 16) { phase_gla(p, i, shm, 0); break; }
        const int Gv = G == 256 ? 240 : G, vb = G == 256 ? bid - 16 : bid;
        for (int q = 0; q < 2; ++q) {
            const bf16_t* A; const bf16_t* Bt; int Mr, N, K, c = vb; EpiBf E;
            if (q == 0) { A = (const bf16_t*)(ws + W_CQN); Bt = (const bf16_t*)(ws + W_QB) + (size_t)i * 768 * 384; Mr = M; N = 768; K = 384; E.O = (bf16_t*)(ws + W_QM); E.ldc = 768; }
            else { A = (const bf16_t*)(ws + W_CKVN); Bt = (const bf16_t*)(ws + W_KVB) + (size_t)i * 1024 * 256; Mr = MKV; N = 1024; K = 256; E.O = (bf16_t*)(ws + W_KVM); E.ldc = 1024;
                c = (vb + Gv - 120) % Gv; }
            run_gemm<EpiBf>(shm, A, Bt, Mr, N, K, c, E, Gv);
        }
    } break;
    case OP_OUTPROJ: case OP_FFNOUT: {
        const bf16_t* A; const bf16_t* Bt; int K; EpiResN E; E.X = p.out; E.S0 = p.out; E.S1 = p.out + (size_t)MC * 1024; E.H = (bf16_t*)(ws + W_H);
        const float* modb = (const float*)(ws + W_MOD);
        const float* mod = modb + (size_t)l * 6144;
        if (op == OP_OUTPROJ) { A = (const bf16_t*)(ws + W_MIX); K = 1024; Bt = isab ? (const bf16_t*)(ws + W_ABO) + (size_t)i * 1024 * 1024 : (const bf16_t*)(ws + W_GQO) + (size_t)i * 1024 * 1024; E.gate = mod + 2048;
            if (l == 0) { E.S0 = p.in[0]; E.S1 = p.in[1]; }
            E.gn = p.in[12] + l * 1024; E.scn = mod + 4096; E.rssn = (float*)(ws + W_RSS) + (size_t)(2 * l + 1) * M; }
        else { A = (const bf16_t*)(ws + W_FFNH); K = 2816; Bt = (const bf16_t*)(ws + W_FFO) + (size_t)l * 1024 * 2816; E.gate = mod + 5120;
            if (l < 3) { E.gn = p.in[11] + (l + 1) * 1024; E.scn = modb + (size_t)(l + 1) * 6144 + 1024; E.rssn = (float*)(ws + W_RSS) + (size_t)(2 * l + 2) * M; }
            else { E.H = nullptr; E.gn = p.in[11]; E.scn = modb; E.rssn = nullptr; } }
        if (bid >= 160 && G == 256) {
            const int vw = (bid - 160) * 8 + (tid_o() >> 6);
            if (op == OP_OUTPROJ) { if (l < 3) prep_layer(p, l + 1, 1, bid - 160, 96, shm); bias_ffn(p, l, vw, 96 * 8); }
            else if (l < 3) { prep_layer(p, l + 1, 2, bid - 160, 96, shm); bias_in(p, l + 1, vw, 96 * 8); }
        } else run_gemm<EpiResN>(shm, A, Bt, M, 1024, K, bid, E);
    } break;
    case OP_FFNIN: {
        EpiSwiN E; E.O = (bf16_t*)(ws + W_FFNH); E.rss = rssb + (size_t)(2 * l + 1) * M; E.bias = (const float*)(ws + W_BIASF) + (size_t)l * 3 * 5632;
        run_gemm<EpiSwiN>(shm, (const bf16_t*)(ws + W_H), (const bf16_t*)(ws + W_FFI) + (size_t)l * 5632 * 1024, M, 5632, 1024, bid, E);
        if (l < 3 && bid >= 112 && G == 256) prep_layer(p, l + 1, 4, bid - 112, 144, shm);
    } break;
    }
}

template <bool COOP>
__global__ __launch_bounds__(512, 2) void mega(P p, int ph0, int ph1) {
    extern __shared__ __attribute__((aligned(16))) char shm[];
    __shared__ uint4 xb_words;
    XcdBarrier xb;
    if (COOP) {
        if (ph1 < 0) cg::this_grid().sync();
        if (threadIdx.x == 0) xb_words = make_uint4(0u, 0u, 0u, 0u);
        __syncthreads();
        xb = xcd_barrier_post((unsigned*)(p.ws + W_BAR), (volatile LAS unsigned*)&xb_words);
    }
    for (int ph = ph0; ph < ph1; ++ph) {
        run_phase(p, ph, shm);
        if (COOP) { if (ph + 1 < ph1) xcd_barrier(xb); }
    }
}

extern "C" void kernel_launch(void* const* d_in, const int* in_sizes, int n_in, void* d_out, int out_size, void* d_ws, size_t ws_size, hipStream_t stream) {
    static int grid = 0;
    if (grid == 0) {
        int dev = 0, cus = 0, per_cu = 0;
        hipGetDevice(&dev);
        hipDeviceGetAttribute(&cus, hipDeviceAttributeMultiprocessorCount, dev);
        hipFuncSetAttribute((const void*)mega<true>, hipFuncAttributeMaxDynamicSharedMemorySize, LDS_BYTES);
        hipFuncSetAttribute((const void*)mega<false>, hipFuncAttributeMaxDynamicSharedMemorySize, LDS_BYTES);
        hipOccupancyMaxActiveBlocksPerMultiprocessor(&per_cu, (const void*)mega<true>, NTH, LDS_BYTES);
        if (per_cu < 1) per_cu = 1;
        grid = cus * per_cu;
        if (grid > 256) grid = 256;
        (void)hipGetLastError();
        if (ws_size < W_END2) fprintf(stderr, "kernel_launch: workspace too small: %zu < %zu\n", ws_size, (size_t)W_END2);
    }
    P p{};
    for (int k = 0; k < 30; ++k) p.in[k] = (const float*)d_in[k];
    p.out = (float*)d_out; p.ws = (char*)d_ws;
#if MULTI_LAUNCH
    for (int ph = 0; ph < NPHASE; ++ph) hipLaunchKernelGGL(mega<false>, dim3(grid), dim3(NTH), LDS_BYTES, stream, p, ph, ph + 1);
#else
    (void)hipMemsetAsync((char*)d_ws + W_BAR, 0, 16384, stream);
    int ph0 = 0, ph1 = NPHASE;
    void* args[] = {&p, &ph0, &ph1};
    hipError_t e = hipLaunchCooperativeKernel((const void*)mega<true>, dim3(grid), dim3(NTH), args, LDS_BYTES, stream);
    if (e != hipSuccess) fprintf(stderr, "cooperative launch failed: %s (grid %d)\n", hipGetErrorString(e), grid);
#endif
}
```

```cpp
#include <hip/hip_runtime.h>
#include <hip/hip_cooperative_groups.h>
#include <cstdio>
namespace cg = cooperative_groups;

#ifndef PROBE_MASK
#define PROBE_MASK 0
#endif
#ifndef MULTI_LAUNCH
#define MULTI_LAUNCH 0
#endif

#define DI __device__ __forceinline__
#define LAS __attribute__((address_space(3)))
typedef unsigned short bf16_t;
typedef short bf16x8 __attribute__((ext_vector_type(8)));
typedef short s16x4 __attribute__((ext_vector_type(4)));
typedef float f32x4 __attribute__((ext_vector_type(4)));
typedef unsigned u32x4 __attribute__((ext_vector_type(4)));
typedef unsigned u32x2 __attribute__((ext_vector_type(2)));

constexpr int MC = 8192, MLAT = 2048, M = 10240, MKV = 11264;
constexpr int NTH = 512;
constexpr int LDS_BYTES = 131072;
constexpr float EPS = 1e-6f;
constexpr float LOG2E = 1.4426950408889634f;

constexpr size_t O_CKV = 10485760, O_KPE = 14680064, O_GLA = 15204352, O_K = 19398656, O_V = 23592960;

constexpr size_t al256(size_t x) { return (x + 255) & ~(size_t)255; }
constexpr size_t W_MOD = 0;
constexpr size_t W_H = al256(W_MOD + 3 * 4 * 6144 * 4);
constexpr size_t W_PROJ = al256(W_H + (size_t)M * 1024 * 2);
constexpr size_t W_QP = al256(W_PROJ + (size_t)M * 2304 * 2);
constexpr size_t W_KP = al256(W_QP + (size_t)M * 1024 * 2);
constexpr size_t W_VT = al256(W_KP + (size_t)MKV * 768 * 2);
constexpr size_t W_MIX = al256(W_VT + (size_t)MKV * 512 * 2);
constexpr size_t W_LA = al256(W_MIX + (size_t)M * 1024 * 2);
constexpr size_t W_ODIR = al256(W_LA + (size_t)2 * M * 256 * 4);
constexpr size_t W_FFNH = al256(W_ODIR + (size_t)2 * M * 512 * 4);
constexpr size_t W_KVM = W_FFNH;
constexpr size_t W_QM = al256(W_KVM + (size_t)MKV * 1024 * 2);
constexpr size_t W_CQN = al256(W_QM + (size_t)M * 768 * 2);
constexpr size_t W_CKVN = al256(W_CQN + (size_t)M * 384 * 2);
constexpr size_t W_ALIAS_END = al256(W_CKVN + (size_t)MKV * 256 * 2);
constexpr size_t W_FFNH_END = al256(W_FFNH + (size_t)M * 2816 * 2);
static_assert(W_ALIAS_END <= W_FFNH_END, "alias overflow");
constexpr size_t W_FFI = W_FFNH_END;
constexpr size_t W_FFO = al256(W_FFI + (size_t)4 * 5632 * 1024 * 2);
constexpr size_t W_ABI = al256(W_FFO + (size_t)4 * 1024 * 2816 * 2);
constexpr size_t W_ABO = al256(W_ABI + (size_t)2 * 2304 * 1024 * 2);
constexpr size_t W_QB = al256(W_ABO + (size_t)2 * 1024 * 1024 * 2);
constexpr size_t W_KVB = al256(W_QB + (size_t)2 * 768 * 384 * 2);
constexpr size_t W_GQI = al256(W_KVB + (size_t)2 * 1024 * 256 * 2);
constexpr size_t W_GQO = al256(W_GQI + (size_t)2 * 1536 * 1024 * 2);
constexpr size_t W_END = al256(W_GQO + (size_t)2 * 1024 * 1024 * 2);
constexpr size_t W_BAR = W_END;
constexpr size_t W_RSS = W_BAR + 16384;
constexpr size_t W_BIASI = al256(W_RSS + (size_t)8 * M * 4);
constexpr size_t W_BIASF = al256(W_BIASI + (size_t)4 * 3 * 2304 * 4);
constexpr size_t W_GST = al256(W_BIASF + (size_t)4 * 3 * 5632 * 4);
constexpr size_t W_END2 = al256(W_GST + (size_t)16 * 512 * 16 * 4);
static_assert(W_END2 <= (size_t)402653184, "workspace too large");

struct P { const float* in[30]; float* out; char* ws; };

DI unsigned pk(float lo, float hi) { unsigned r; asm("v_cvt_pk_bf16_f32 %0, %1, %2" : "=v"(r) : "v"(lo), "v"(hi)); return r; }
DI float bf2f(bf16_t b) { return __uint_as_float((unsigned)b << 16); }
DI float bflo(unsigned u) { return __uint_as_float(u << 16); }
DI float bfhi(unsigned u) { return __uint_as_float(u & 0xffff0000u); }
DI bf16_t f2bf(float x) { return (bf16_t)(pk(x, 0.f) & 0xffffu); }
DI float silu_f(float x) { return x * __builtin_amdgcn_rcpf(1.f + __expf(-x)); }
DI f32x4 mfma16(bf16x8 a, bf16x8 b, f32x4 c) { return __builtin_amdgcn_mfma_f32_16x16x32_bf16(a, b, c, 0, 0, 0); }
DI int tid_o() { int t = threadIdx.x; asm volatile("" : "+v"(t)); return t; }
DI int bid_o() { int t = blockIdx.x; asm volatile("" : "+s"(t)); return t; }
DI float wave_sum(float v) {
#pragma unroll
    for (int o = 1; o < 64; o <<= 1) v += __shfl_xor(v, o);
    return v;
}


#define XB_TMO      128
#define XB_XCNT(j)  (256  + 64 * (j))
#define XB_XSUB(j)  (1280 + 64 * (j))
#define XB_XGEN(j)  (2304 + 64 * (j))
#define XB_TOP      3328
#define XB_TOPGEN   3392
#define XCD_BAR_WORDS 3456
#define XB_SPIN_CAP (1u << 20)
DI unsigned xb_ld(unsigned* p)              { return __hip_atomic_load(p, __ATOMIC_RELAXED, __HIP_MEMORY_SCOPE_AGENT); }
DI unsigned xb_add(unsigned* p, unsigned v) { return __hip_atomic_fetch_add(p, v, __ATOMIC_RELAXED, __HIP_MEMORY_SCOPE_AGENT); }
DI unsigned xb_xcc_id() { return (unsigned)__builtin_amdgcn_s_getreg((3 << 11) | 20) & 0xFu; }
#define XB_SPIN(cond, bar) do { unsigned _sp = 0; while (cond) { __builtin_amdgcn_s_sleep(1); \
    if ((++_sp & 255u) == 0u) { if (xb_ld(&(bar)[XB_TMO])) break; if (_sp > XB_SPIN_CAP) { atomicAdd(&(bar)[XB_TMO], 1u); break; } } } } while (0)
struct XcdBarrier { unsigned* bar; unsigned x; volatile LAS unsigned* st; };
DI XcdBarrier xcd_barrier_post(unsigned* bar, volatile LAS unsigned* st) {
    XcdBarrier b; b.bar = bar; b.x = xb_xcc_id(); b.st = st;
    if (threadIdx.x == 0) (void)xb_add(&bar[XB_XCNT(b.x)], 1u);
    return b;
}
DI void xcd_barrier_complete(unsigned* bar, unsigned x, unsigned& nloc, unsigned& nx) {
    const unsigned G = gridDim.x * gridDim.y * gridDim.z;
    unsigned sum, cnt, mine, sp = 0u;
    for (;;) {
        sum = 0u; cnt = 0u; mine = 0u;
#pragma unroll
        for (unsigned j = 0; j < 16; ++j) { const unsigned c = xb_ld(&bar[XB_XCNT(j)]); sum += c; cnt += (c > 0u) ? 1u : 0u; mine = (j == x) ? c : mine; }
        if (sum == G) break;
        __builtin_amdgcn_s_sleep(1);
        if ((++sp & 255u) == 0u) { if (xb_ld(&bar[XB_TMO])) break; if (sp > XB_SPIN_CAP) { atomicAdd(&bar[XB_TMO], 1u); break; } }
    }
    nloc = mine > 0u ? mine : 1u; nx = cnt > 0u ? cnt : 1u;
}
DI void xcd_barrier(const XcdBarrier& b) {
    asm volatile("s_waitcnt vmcnt(0)" ::: "memory");
    __syncthreads();
    if (threadIdx.x == 0) {
        unsigned* bar = b.bar;
        __builtin_amdgcn_s_waitcnt(0);
        unsigned nloc = b.st[0], nx = b.st[1];
        if (nloc == 0u) { xcd_barrier_complete(bar, b.x, nloc, nx); b.st[0] = nloc; b.st[1] = nx; }
        const unsigned old = xb_add(&bar[XB_XSUB(b.x)], 1u);
        const unsigned gen = old / nloc;
        if (old + 1u == (gen + 1u) * nloc) {
            __builtin_amdgcn_fence(__ATOMIC_RELEASE, "agent");
            asm volatile("s_waitcnt vmcnt(0)" ::: "memory");
            const unsigned og = xb_add(&bar[XB_TOP], 1u);
            const unsigned tg = og / nx;
            if (og + 1u == (tg + 1u) * nx) xb_add(&bar[XB_TOPGEN], 1u);
            else XB_SPIN(xb_ld(&bar[XB_TOPGEN]) == tg, bar);
            __builtin_amdgcn_fence(__ATOMIC_ACQUIRE, "agent");
            xb_add(&bar[XB_XGEN(b.x)], 1u);
            asm volatile("s_waitcnt vmcnt(0)" ::: "memory");
        } else {
            XB_SPIN(xb_ld(&bar[XB_XGEN(b.x)]) == gen, bar);
            __builtin_amdgcn_fence(__ATOMIC_ACQUIRE, "agent");
            asm volatile("s_waitcnt vmcnt(0)" ::: "memory");
        }
    }
    __syncthreads();
}

namespace pg8 {
constexpr int BM = 256, BK = 64, HALF = 128, HTB = HALF * BK * 2, STAGE_BYTES = 8 * HTB, NXCD = 8, WGM = 8;
DI int lds_byte(int r, int c) { const int st = (r >> 4) * 2 + (c >> 5), rr = r & 15, cc = c & 31, ob = rr * 64 + cc * 2; return st * 1024 + (ob ^ (((ob >> 9) & 1) << 5)); }
DI void stage_rc(int b, int& R, int& C) { const int st = b / 1024, sb = b % 1024, swz = sb ^ (((sb >> 9) & 1) << 5); R = (st >> 1) * 16 + swz / 64; C = (st & 1) * 32 + (swz % 64) / 2; }
DI int perm32(int rho) { const int n = rho >> 4, i = rho & 15; return 8 * (i >> 2) + 4 * n + (i & 3); }
struct Unit { int pm, pn; };
struct Gemm { const bf16_t* A; const bf16_t* Bt; int M, N, K; };
struct StaticOrder {
    int nM, nN, nwg, G, c;
    DI void init(int M_, int N_, int G_, int c_) { nM = M_ / BM; nN = N_ / BM; nwg = nM * nN; G = G_; c = c_; }
    DI bool next(int i, Unit& u) const {
        const long L = (long)i * G + c; if (L >= nwg) return false;
        int wgid = (int)L; { const int q = nwg / NXCD, r = nwg % NXCD, xcd = wgid % NXCD, off = wgid / NXCD; wgid = (xcd < r ? xcd * (q + 1) : r * (q + 1) + (xcd - r) * q) + off; }
        const int nig = WGM * nN, gid = wgid / nig, fm = gid * WGM, gsz = (nM - fm) < WGM ? (nM - fm) : WGM;
        u.pm = fm + ((wgid % nig) % gsz); u.pn = (wgid % nig) / gsz; return true;
    }
};

template <class Epi>
DI void gemm_phase(LAS unsigned char* lds, const Gemm g, const StaticOrder& S, const Epi& E) {
    const int tid = tid_o(), wid = __builtin_amdgcn_readfirstlane(tid >> 6), lane = tid & 63, wr = wid >> 2, wc = wid & 3, fr = lane & 15, fq = lane >> 4;
    const int K = g.K, nt = K / BK;
    unsigned voffA[2], voffB[2];
#pragma unroll
    for (int i = 0; i < 2; ++i) { int R, C; stage_rc(tid * 16 + i * 8192, R, C); const int Rb = Epi::PERM ? ((R & ~31) + perm32(R & 31)) : R;
        voffA[i] = (unsigned)(R * K + C) * 2u; voffB[i] = (unsigned)(Rb * K + C) * 2u; }
    const size_t kstep = (size_t)(BK * 2);
    const size_t hstep = (size_t)HALF * K * 2;
    const size_t tstep = 2 * hstep;
    const unsigned ldsw = (unsigned)wid * 1024u;
    const int aoff = lds_byte(wr * 64 + fr, fq * 8), boff = lds_byte(wc * 32 + fr, fq * 8);
#define PG8_SA(b, h) (((b) * 2 + (h)) * HTB)
#define PG8_SB(b, h) ((4 + (b) * 2 + (h)) * HTB)
#define PG8_STAGE(bufoff, gbase, voff) do { _Pragma("unroll") for (int _i = 0; _i < 2; ++_i) \
        __builtin_amdgcn_global_load_lds((const unsigned*)((const char*)(gbase) + (voff)[_i]), (LAS unsigned*)(lds + (bufoff) + ldsw + _i * 8192), 16, 0, 0); } while (0)
#define PG8_LDA(dst, b, h) do { _Pragma("unroll") for (int m = 0; m < 4; ++m) _Pragma("unroll") for (int k = 0; k < 2; ++k) dst[m][k] = *(const LAS bf16x8*)(lds + PG8_SA(b, h) + aoff + m * 2048 + k * 1024); } while (0)
#define PG8_LDB(dst, b, h) do { _Pragma("unroll") for (int n = 0; n < 2; ++n) _Pragma("unroll") for (int k = 0; k < 2; ++k) dst[n][k] = *(const LAS bf16x8*)(lds + PG8_SB(b, h) + boff + n * 2048 + k * 1024); } while (0)
#define PG8_MMA(ai, bj, At, Bt) do { __builtin_amdgcn_s_setprio(1); _Pragma("unroll") for (int m = 0; m < 4; ++m) _Pragma("unroll") for (int n = 0; n < 2; ++n) _Pragma("unroll") for (int k = 0; k < 2; ++k) \
        acc[ai][bj][m][n] = __builtin_amdgcn_mfma_f32_16x16x32_bf16(Bt[n][k], At[m][k], acc[ai][bj][m][n], 0, 0, 0); __builtin_amdgcn_s_setprio(0); } while (0)
#define PG8_WAIT_V(n) asm volatile("s_waitcnt vmcnt(" #n ")" ::: "memory")
#define PG8_WAIT_L(n) asm volatile("s_waitcnt lgkmcnt(" #n ")" ::: "memory")
#define PG8_BAR __builtin_amdgcn_s_barrier()
#define PG8_SCHED __builtin_amdgcn_sched_barrier(0)
    Unit cur, nxt; int ui = 0;
    if (!S.next(0, cur)) return;
    f32x4 acc[2][2][4][2];
#pragma unroll
    for (int a = 0; a < 2; ++a)
#pragma unroll
        for (int b = 0; b < 2; ++b)
#pragma unroll
            for (int m = 0; m < 4; ++m)
#pragma unroll
                for (int n = 0; n < 2; ++n) acc[a][b][m][n] = (f32x4){0.f, 0.f, 0.f, 0.f};
    bf16x8 At[4][2], B0[2][2], B1[2][2];
    const char* cA = (const char*)g.A + (size_t)cur.pm * tstep; const char* cB = (const char*)g.Bt + (size_t)cur.pn * tstep;
    PG8_STAGE(PG8_SB(0, 0), cB, voffB); PG8_STAGE(PG8_SA(0, 0), cA, voffA); PG8_STAGE(PG8_SB(0, 1), cB + hstep, voffB); PG8_STAGE(PG8_SA(0, 1), cA + hstep, voffA);
    if (wr == 1) PG8_BAR;
    PG8_WAIT_V(4); PG8_BAR;
    PG8_STAGE(PG8_SB(1, 0), cB + kstep, voffB); PG8_STAGE(PG8_SA(1, 0), cA + kstep, voffA); PG8_STAGE(PG8_SB(1, 1), cB + hstep + kstep, voffB);
    PG8_WAIT_V(6); PG8_BAR;
    for (;;) {
        const bool has_next = S.next(ui + 1, nxt);
        const char* nA = has_next ? (const char*)g.A + (size_t)nxt.pm * tstep : cA; const char* nB = has_next ? (const char*)g.Bt + (size_t)nxt.pn * tstep : cB;
        for (int t = 0; t < nt; t += 2) {
            const bool last = (t == nt - 2);
            const char* a1 = cA + (size_t)(t + 1) * kstep;
            const char* a2 = last ? nA : cA + (size_t)(t + 2) * kstep; const char* b2 = last ? nB : cB + (size_t)(t + 2) * kstep;
            const char* a3 = a2 + kstep; const char* b3 = b2 + kstep;
            PG8_LDB(B0, 0, 0); PG8_SCHED; PG8_LDA(At, 0, 0); PG8_STAGE(PG8_SA(1, 1), a1 + hstep, voffA);
            PG8_WAIT_L(8); PG8_BAR; PG8_WAIT_L(0); PG8_MMA(0, 0, At, B0); PG8_BAR; PG8_SCHED;
            PG8_LDB(B1, 0, 1); PG8_STAGE(PG8_SB(0, 0), b2, voffB);
            PG8_BAR; PG8_WAIT_L(0); PG8_MMA(0, 1, At, B1); PG8_BAR;
            PG8_LDA(At, 0, 1); PG8_STAGE(PG8_SA(0, 0), a2, voffA);
            PG8_BAR; PG8_WAIT_L(0); PG8_MMA(1, 0, At, B0); PG8_BAR; PG8_SCHED;
            PG8_STAGE(PG8_SB(0, 1), b2 + hstep, voffB);
            PG8_WAIT_V(6); PG8_BAR; PG8_MMA(1, 1, At, B1); PG8_BAR;
            PG8_LDB(B0, 1, 0); PG8_SCHED; PG8_LDA(At, 1, 0); PG8_STAGE(PG8_SA(0, 1), a2 + hstep, voffA);
            PG8_WAIT_L(8); PG8_BAR; PG8_WAIT_L(0); PG8_MMA(0, 0, At, B0); PG8_BAR; PG8_SCHED;
            PG8_LDB(B1, 1, 1); PG8_STAGE(PG8_SB(1, 0), b3, voffB);
            PG8_BAR; PG8_WAIT_L(0); PG8_MMA(0, 1, At, B1); PG8_BAR;
            PG8_LDA(At, 1, 1); PG8_STAGE(PG8_SA(1, 0), a3, voffA);
            PG8_BAR; PG8_WAIT_L(0); PG8_MMA(1, 0, At, B0); PG8_BAR; PG8_SCHED;
            PG8_STAGE(PG8_SB(1, 1), b3 + hstep, voffB);
            PG8_WAIT_V(6); PG8_BAR; PG8_MMA(1, 1, At, B1); PG8_BAR;
        }
        E(acc, cur, wr, wc, fr, fq);
        if (!has_next) break;
#pragma unroll
        for (int a = 0; a < 2; ++a)
#pragma unroll
            for (int b = 0; b < 2; ++b)
#pragma unroll
                for (int m = 0; m < 4; ++m)
#pragma unroll
                    for (int n = 0; n < 2; ++n) acc[a][b][m][n] = (f32x4){0.f, 0.f, 0.f, 0.f};
        cur = nxt; cA = nA; cB = nB; ++ui;
    }
    PG8_WAIT_V(0);
    if (wr == 0) PG8_BAR;
    PG8_BAR;
#undef PG8_SA
#undef PG8_SB
#undef PG8_STAGE
#undef PG8_LDA
#undef PG8_LDB
#undef PG8_MMA
#undef PG8_WAIT_V
#undef PG8_WAIT_L
#undef PG8_BAR
#undef PG8_SCHED
}
}

struct EpiBf {
    static constexpr bool PERM = true;
    bf16_t* O; int ldc;
    DI void operator()(const f32x4 (&acc)[2][2][4][2], const pg8::Unit& u, int wr, int wc, int fr, int fq) const {
        const int row0 = u.pm * 256 + wr * 64 + fr, col0 = u.pn * 256 + wc * 32 + 8 * fq;
#pragma unroll
        for (int ai = 0; ai < 2; ++ai)
#pragma unroll
            for (int m = 0; m < 4; ++m) { bf16_t* rowp = O + (size_t)(row0 + ai * 128 + m * 16) * ldc + col0;
#pragma unroll
                for (int bj = 0; bj < 2; ++bj) { const f32x4 v0 = acc[ai][bj][m][0], v1 = acc[ai][bj][m][1];
                    u32x4 w; w.x = pk(v0[0], v0[1]); w.y = pk(v0[2], v0[3]); w.z = pk(v1[0], v1[1]); w.w = pk(v1[2], v1[3]);
                    *(u32x4*)(rowp + bj * 128) = w; } }
    }
};
struct EpiSwi {
    static constexpr bool PERM = true;
    bf16_t* O;
    DI void operator()(const f32x4 (&acc)[2][2][4][2], const pg8::Unit& u, int wr, int wc, int fr, int fq) const {
        const int row0 = u.pm * 256 + wr * 64 + fr, col0 = u.pn * 128 + wc * 32 + 8 * fq;
#pragma unroll
        for (int ai = 0; ai < 2; ++ai)
#pragma unroll
            for (int m = 0; m < 4; ++m) { bf16_t* rowp = O + (size_t)(row0 + ai * 128 + m * 16) * 2816 + col0;
                float r[8];
#pragma unroll
                for (int n = 0; n < 2; ++n)
#pragma unroll
                    for (int j = 0; j < 4; ++j) { const float g = acc[ai][0][m][n][j], uu = acc[ai][1][m][n][j]; r[n * 4 + j] = silu_f(g) * uu; }
                u32x4 w; w.x = pk(r[0], r[1]); w.y = pk(r[2], r[3]); w.z = pk(r[4], r[5]); w.w = pk(r[6], r[7]);
                *(u32x4*)rowp = w; }
    }
};
struct EpiRes {
    static constexpr bool PERM = false;
    float* X; const float* gate; const float* S0; const float* S1;
    DI void operator()(const f32x4 (&acc)[2][2][4][2], const pg8::Unit& u, int wr, int wc, int fr, int fq) const {
        const int row0 = u.pm * 256 + wr * 64 + fr, col0 = u.pn * 256 + wc * 32 + 4 * fq;
        const int grp = u.pm < 32 ? 0 : 1 + ((u.pm - 32) >> 2);
        const float* gp = gate + (size_t)grp * 4 * 6144 + col0;
        f32x4 gv[2][2];
#pragma unroll
        for (int bj = 0; bj < 2; ++bj)
#pragma unroll
            for (int n = 0; n < 2; ++n) gv[bj][n] = *(const f32x4*)(gp + bj * 128 + n * 16);
#pragma unroll
        for (int ai = 0; ai < 2; ++ai)
#pragma unroll
            for (int m = 0; m < 4; ++m) { const int row = row0 + ai * 128 + m * 16; float* rowp = X + (size_t)row * 1024 + col0;
                const float* srow = (u.pm < 32 ? S0 + (size_t)row * 1024 : S1 + (size_t)(row - MC) * 1024) + col0;
#pragma unroll
                for (int bj = 0; bj < 2; ++bj)
#pragma unroll
                    for (int n = 0; n < 2; ++n) { *(f32x4*)(rowp + bj * 128 + n * 16) = *(const f32x4*)(srow + bj * 128 + n * 16) + gv[bj][n] * acc[ai][bj][m][n]; } }
    }
};


struct EpiBfN {
    static constexpr bool PERM = true;
    bf16_t* O; int ldc; const float* rss; const float* bias; int gs;
    DI void operator()(const f32x4 (&acc)[2][2][4][2], const pg8::Unit& u, int wr, int wc, int fr, int fq) const {
        const int row0 = u.pm * 256 + wr * 64 + fr, col0 = u.pn * 256 + wc * 32 + 8 * fq;
        const int grp = u.pm < 32 ? 0 : 1 + ((u.pm - 32) >> 2);
        const float* bp = bias + (size_t)grp * gs + col0;
        f32x4 b[2][2];
#pragma unroll
        for (int bj = 0; bj < 2; ++bj)
#pragma unroll
            for (int n = 0; n < 2; ++n) b[bj][n] = *(const f32x4*)(bp + bj * 128 + 4 * n);
        float rsv[8];
#pragma unroll
        for (int k = 0; k < 8; ++k) rsv[k] = rss[row0 + (k >> 2) * 128 + (k & 3) * 16];
        asm volatile("" : "+v"(rsv[0]), "+v"(rsv[1]), "+v"(rsv[2]), "+v"(rsv[3]), "+v"(rsv[4]), "+v"(rsv[5]), "+v"(rsv[6]), "+v"(rsv[7]), "+v"(b[0][0]), "+v"(b[0][1]), "+v"(b[1][0]), "+v"(b[1][1]));
#pragma unroll
        for (int k = 0; k < 8; ++k) rsv[k] = rsqrtf(rsv[k] * (1.f / 1024.f) + EPS);
#pragma unroll
        for (int ai = 0; ai < 2; ++ai)
#pragma unroll
            for (int m = 0; m < 4; ++m) { const int row = row0 + ai * 128 + m * 16; bf16_t* rowp = O + (size_t)row * ldc + col0;
                const float rs = rsv[ai * 4 + m];
#pragma unroll
                for (int bj = 0; bj < 2; ++bj) { const f32x4 v0 = acc[ai][bj][m][0] * rs + b[bj][0], v1 = acc[ai][bj][m][1] * rs + b[bj][1];
                    u32x4 w; w.x = pk(v0[0], v0[1]); w.y = pk(v0[2], v0[3]); w.z = pk(v1[0], v1[1]); w.w = pk(v1[2], v1[3]);
                    *(u32x4*)(rowp + bj * 128) = w; } }
    }
};
struct EpiSwiN {
    static constexpr bool PERM = true;
    bf16_t* O; const float* rss; const float* bias;
    DI void operator()(const f32x4 (&acc)[2][2][4][2], const pg8::Unit& u, int wr, int wc, int fr, int fq) const {
        const int row0 = u.pm * 256 + wr * 64 + fr, col0 = u.pn * 128 + wc * 32 + 8 * fq;
        const int grp = u.pm < 32 ? 0 : 1 + ((u.pm - 32) >> 2);
        const float* bp = bias + (size_t)grp * 5632 + u.pn * 256 + wc * 32 + 8 * fq;
        f32x4 bg[2], bu[2];
#pragma unroll
        for (int n = 0; n < 2; ++n) { bg[n] = *(const f32x4*)(bp + 4 * n); bu[n] = *(const f32x4*)(bp + 128 + 4 * n); }
        float rsv[8];
#pragma unroll
        for (int k = 0; k < 8; ++k) rsv[k] = rss[row0 + (k >> 2) * 128 + (k & 3) * 16];
        asm volatile("" : "+v"(rsv[0]), "+v"(rsv[1]), "+v"(rsv[2]), "+v"(rsv[3]), "+v"(rsv[4]), "+v"(rsv[5]), "+v"(rsv[6]), "+v"(rsv[7]), "+v"(bg[0]), "+v"(bg[1]), "+v"(bu[0]), "+v"(bu[1]));
#pragma unroll
        for (int k = 0; k < 8; ++k) rsv[k] = rsqrtf(rsv[k] * (1.f / 1024.f) + EPS);
#pragma unroll
        for (int ai = 0; ai < 2; ++ai)
#pragma unroll
            for (int m = 0; m < 4; ++m) { const int row = row0 + ai * 128 + m * 16; bf16_t* rowp = O + (size_t)row * 2816 + col0;
                const float rs = rsv[ai * 4 + m];
                float r[8];
#pragma unroll
                for (int n = 0; n < 2; ++n)
#pragma unroll
                    for (int j = 0; j < 4; ++j) { const float g = acc[ai][0][m][n][j] * rs + bg[n][j], uu = acc[ai][1][m][n][j] * rs + bu[n][j]; r[n * 4 + j] = silu_f(g) * uu; }
                u32x4 w; w.x = pk(r[0], r[1]); w.y = pk(r[2], r[3]); w.z = pk(r[4], r[5]); w.w = pk(r[6], r[7]);
                *(u32x4*)rowp = w; }
    }
};
struct EpiResN {
    static constexpr bool PERM = false;
    float* X; const float* gate; const float* S0; const float* S1; bf16_t* H; const float* gn; const float* scn; float* rssn;
    DI void operator()(const f32x4 (&acc)[2][2][4][2], const pg8::Unit& u, int wr, int wc, int fr, int fq) const {
        const int row0 = u.pm * 256 + wr * 64 + fr, col0 = u.pn * 256 + wc * 32 + 4 * fq;
        const int grp = u.pm < 32 ? 0 : 1 + ((u.pm - 32) >> 2);
        const float* gp = gate + (size_t)grp * 4 * 6144 + col0;
        const bool nxt = H != nullptr;
        f32x4 gv[2][2], cs[2][2];
#pragma unroll
        for (int bj = 0; bj < 2; ++bj)
#pragma unroll
            for (int n = 0; n < 2; ++n) { const int co = bj * 128 + n * 16; gv[bj][n] = *(const f32x4*)(gp + co);
                cs[bj][n] = nxt ? *(const f32x4*)(gn + col0 + co) * (1.f + *(const f32x4*)(scn + (size_t)grp * 4 * 6144 + col0 + co)) : (f32x4){0.f, 0.f, 0.f, 0.f}; }
        const float* sbase = (u.pm < 32 ? S0 + (size_t)row0 * 1024 : S1 + (size_t)(row0 - MC) * 1024) + col0;
        f32x4 xb[2][2][2][2];
#pragma unroll
        for (int r = 0; r < 2; ++r)
#pragma unroll
            for (int bj = 0; bj < 2; ++bj)
#pragma unroll
                for (int n = 0; n < 2; ++n) xb[0][r][bj][n] = *(const f32x4*)(sbase + (size_t)(r * 16) * 1024 + bj * 128 + n * 16);
#pragma unroll
        for (int bt = 0; bt < 4; ++bt) {
            if (bt < 3) {
#pragma unroll
                for (int r = 0; r < 2; ++r) { const int k1 = (bt + 1) * 2 + r, ro1 = (k1 >> 2) * 128 + (k1 & 3) * 16;
#pragma unroll
                    for (int bj = 0; bj < 2; ++bj)
#pragma unroll
                        for (int n = 0; n < 2; ++n) xb[(bt + 1) & 1][r][bj][n] = *(const f32x4*)(sbase + (size_t)ro1 * 1024 + bj * 128 + n * 16); }
            }
#pragma unroll
            for (int r = 0; r < 2; ++r) {
                const int k = bt * 2 + r, ai = k >> 2, m = k & 3, ro = ai * 128 + m * 16;
                float part = 0.f;
                float* xrow = X + (size_t)(row0 + ro) * 1024 + col0; bf16_t* hrow = H + (size_t)(row0 + ro) * 1024 + col0;
#pragma unroll
                for (int bj = 0; bj < 2; ++bj)
#pragma unroll
                    for (int n = 0; n < 2; ++n) { const int co = bj * 128 + n * 16;
                        const f32x4 xn = xb[bt & 1][r][bj][n] + gv[bj][n] * acc[ai][bj][m][n];
                        if (nxt) *(f32x4*)(xrow + co) = xn; else __builtin_nontemporal_store(xn, (f32x4*)(xrow + co));
                        if (nxt) { const f32x4 a = xn * cs[bj][n]; u32x2 w; w.x = pk(a[0], a[1]); w.y = pk(a[2], a[3]); *(u32x2*)(hrow + co) = w;
                            part += xn[0] * xn[0] + xn[1] * xn[1] + xn[2] * xn[2] + xn[3] * xn[3]; } }
                if (nxt) { part += __shfl_xor(part, 16); part += __shfl_xor(part, 32);
                    if (fq == 0) __hip_atomic_fetch_add(rssn + row0 + ro, part, __ATOMIC_RELAXED, __HIP_MEMORY_SCOPE_AGENT); }
            }
        }
    }
};

template <class Epi>
DI void run_gemm(char* shm, const bf16_t* A, const bf16_t* Bt, int Mr, int N, int K, int c, const Epi& E, int Gv = 0) {
    pg8::Gemm g{A, Bt, Mr, N, K};
    pg8::StaticOrder S; S.init(Mr, N, Gv ? Gv : (int)gridDim.x, c);
    pg8::gemm_phase<Epi>((LAS unsigned char*)shm, g, S, E);
}

DI void wtile(const P& p, int l, int part, int j, char* shm) {
    int K, N, Np, per, mode = 0; size_t doff; const float* srcp;
    int r = j; const int i = l >> 1; int layer;
    if (part == 1) {
        layer = l;
        if (r < 1408) { K = 1024; N = 5632; Np = 5632; per = 1408; srcp = p.in[13]; doff = W_FFI; mode = 1; }
        else { r -= 1408; K = 2816; N = 1024; Np = 1024; per = 704; srcp = p.in[14]; doff = W_FFO; }
    } else if ((l & 1) == 0) {
        layer = i;
        if (r < 576) { K = 1024; N = 2240; Np = 2304; per = 576; srcp = p.in[15]; doff = W_ABI; }
        else if ((r -= 576) < 256) { K = 1024; N = 1024; Np = 1024; per = 256; srcp = p.in[16]; doff = W_ABO; }
        else if ((r -= 256) < 72) { K = 384; N = 768; Np = 768; per = 72; srcp = p.in[21]; doff = W_QB; }
        else { r -= 72; K = 256; N = 1024; Np = 1024; per = 64; srcp = p.in[23]; doff = W_KVB; }
    } else {
        layer = i;
        if (r < 384) { K = 1024; N = 1536; Np = 1536; per = 384; srcp = p.in[26]; doff = W_GQI; }
        else { r -= 384; K = 1024; N = 1024; Np = 1024; per = 256; srcp = p.in[27]; doff = W_GQO; }
    }
    (void)per;
    const int tt = r, nkt = K / 64, kt = tt % nkt, ntile = tt / nkt;
    const int k0 = kt * 64, n0 = ntile * 64;
    int n0d = n0;
    if (mode == 1) { const int half = n0 >= 2816 ? 1 : 0, f0 = n0 - half * 2816; n0d = (f0 >> 7) * 256 + half * 128 + (f0 & 127); }
    float* tile = (float*)shm;
    const int tid = tid_o();
    {
        const int k = tid >> 3, n8 = (tid & 7) * 8;
        float4 a = make_float4(0.f, 0.f, 0.f, 0.f), b = a;
        if (n0 < N) { const float* s = srcp + (size_t)layer * K * N + (size_t)(k0 + k) * N + n0 + n8;
            const f32x4 va = __builtin_nontemporal_load((const f32x4*)s), vb = __builtin_nontemporal_load((const f32x4*)(s + 4));
            a = make_float4(va[0], va[1], va[2], va[3]); b = make_float4(vb[0], vb[1], vb[2], vb[3]); }
        float* t = tile + k * 65 + n8;
        t[0] = a.x; t[1] = a.y; t[2] = a.z; t[3] = a.w; t[4] = b.x; t[5] = b.y; t[6] = b.z; t[7] = b.w;
    }
    __syncthreads();
    {
        const int n = tid >> 3, k8 = (tid & 7) * 8;
        const float* t = tile + k8 * 65 + n;
        u32x4 w; w.x = pk(t[0], t[65]); w.y = pk(t[130], t[195]); w.z = pk(t[260], t[325]); w.w = pk(t[390], t[455]);
        bf16_t* d = (bf16_t*)(p.ws + doff) + ((size_t)layer * Np + n0d + n) * K + k0 + k8;
        *(u32x4*)d = w;
    }
    __syncthreads();
}

DI void prep_layer(const P& p, int l, int parts, int vb, int nb, char* shm) {
    const int tid = tid_o();
    if (parts & 4) {
        float* scond = (float*)shm;
        float* red = (float*)(shm + 12288);
        if (vb < 96) {
            for (int k = tid; k < 3072; k += NTH) { const int g = k >> 10, d = k & 1023; const float c = g == 0 ? p.in[8][d] : p.in[2][(g - 1) * 1024 + d]; scond[k] = silu_f(c); }
            __syncthreads();
            float* mod = (float*)(p.ws + W_MOD);
            for (int j = vb; j < 96; j += nb) {
                const int e0 = j * 64, c4 = tid & 15, dg = tid >> 4;
                f32x4 a0 = {0.f, 0.f, 0.f, 0.f}, a1 = a0, a2 = a0;
                const float* w = p.in[9] + ((size_t)l * 1024 + dg * 32) * 6144 + e0 + c4 * 4;
#pragma unroll 8
                for (int dd = 0; dd < 32; ++dd) { const f32x4 wv = __builtin_nontemporal_load((const f32x4*)(w + (size_t)dd * 6144)); const int d = dg * 32 + dd;
                    a0 += scond[d] * wv; a1 += scond[1024 + d] * wv; a2 += scond[2048 + d] * wv; }
                *(f32x4*)(red + (dg * 3 + 0) * 64 + c4 * 4) = a0; *(f32x4*)(red + (dg * 3 + 1) * 64 + c4 * 4) = a1; *(f32x4*)(red + (dg * 3 + 2) * 64 + c4 * 4) = a2;
                __syncthreads();
                if (tid < 192) { const int g = tid >> 6, c = tid & 63; float sm = 0.f;
#pragma unroll 8
                    for (int q = 0; q < 32; ++q) sm += red[(q * 3 + g) * 64 + c];
                    mod[(size_t)(g * 4 + l) * 6144 + e0 + c] = sm + p.in[10][l * 6144 + e0 + c]; }
                __syncthreads();
            }
        }
    }
    if (parts & 1) {
        const int nmix = (l & 1) == 0 ? 968 : 640;
        for (int j = vb; j < nmix; j += nb) wtile(p, l, 0, j, shm);
    }
    if (parts & 2) { for (int j = vb; j < 2112; j += nb) wtile(p, l, 1, j, shm); }
}

DI void bias_rows(const P& p, int l, int which, const bf16_t* Wt, int N, float* out, int vw, int nwv) {
    const int lane = tid_o() & 63;
    const float* mod = (const float*)(p.ws + W_MOD);
    float sh[3][16];
#pragma unroll
    for (int g = 0; g < 3; ++g) { const float* sp = mod + (size_t)(g * 4 + l) * 6144 + which * 3072 + lane * 16;
#pragma unroll
        for (int q = 0; q < 4; ++q) { const f32x4 t = *(const f32x4*)(sp + q * 4); sh[g][q * 4] = t[0]; sh[g][q * 4 + 1] = t[1]; sh[g][q * 4 + 2] = t[2]; sh[g][q * 4 + 3] = t[3]; } }
    for (int n0 = vw; n0 < N; n0 += 4 * nwv) {
        u32x4 w0[4], w1[4];
#pragma unroll
        for (int q = 0; q < 4; ++q) { const int n = n0 + q * nwv < N ? n0 + q * nwv : n0;
            w0[q] = *(const u32x4*)(Wt + (size_t)n * 1024 + lane * 16); w1[q] = *(const u32x4*)(Wt + (size_t)n * 1024 + lane * 16 + 8); }
        float a0[4], a1[4], a2[4];
#pragma unroll
        for (int q = 0; q < 4; ++q) {
            const float wv[16] = {bflo(w0[q].x), bfhi(w0[q].x), bflo(w0[q].y), bfhi(w0[q].y), bflo(w0[q].z), bfhi(w0[q].z), bflo(w0[q].w), bfhi(w0[q].w),
                                  bflo(w1[q].x), bfhi(w1[q].x), bflo(w1[q].y), bfhi(w1[q].y), bflo(w1[q].z), bfhi(w1[q].z), bflo(w1[q].w), bfhi(w1[q].w)};
            float t0 = 0.f, t1 = 0.f, t2 = 0.f;
#pragma unroll
            for (int e = 0; e < 16; ++e) { t0 += sh[0][e] * wv[e]; t1 += sh[1][e] * wv[e]; t2 += sh[2][e] * wv[e]; }
            a0[q] = t0; a1[q] = t1; a2[q] = t2;
        }
#pragma unroll
        for (int o = 1; o < 64; o <<= 1) {
#pragma unroll
            for (int q = 0; q < 4; ++q) { a0[q] += __shfl_xor(a0[q], o); a1[q] += __shfl_xor(a1[q], o); a2[q] += __shfl_xor(a2[q], o); } }
        if (lane == 0) {
#pragma unroll
            for (int q = 0; q < 4; ++q) { const int n = n0 + q * nwv; if (n < N) { out[n] = a0[q]; out[N + n] = a1[q]; out[2 * N + n] = a2[q]; } }
        }
    }
}
DI void bias_in(const P& p, int l, int vw, int nwv) {
    const int i = l >> 1; const bool isab = (l & 1) == 0; const int N = isab ? 2304 : 1536;
    const bf16_t* Wt = isab ? (const bf16_t*)(p.ws + W_ABI) + (size_t)i * 2304 * 1024 : (const bf16_t*)(p.ws + W_GQI) + (size_t)i * 1536 * 1024;
    bias_rows(p, l, 0, Wt, N, (float*)(p.ws + W_BIASI) + (size_t)l * 3 * 2304, vw, nwv);
}
DI void bias_ffn(const P& p, int l, int vw, int nwv) {
    bias_rows(p, l, 1, (const bf16_t*)(p.ws + W_FFI) + (size_t)l * 5632 * 1024, 5632, (float*)(p.ws + W_BIASF) + (size_t)l * 3 * 5632, vw, nwv);
}
DI void phase_first(const P& p) {
    const float* gw = p.in[11];
    const float* mod = (const float*)(p.ws + W_MOD);
    bf16_t* H = (bf16_t*)(p.ws + W_H); float* rss = (float*)(p.ws + W_RSS);
    const int tid_ = tid_o(); const int wave = bid_o() * 8 + (tid_ >> 6), nw = gridDim.x * 8, lane = tid_ & 63;
    for (int row = wave; row < M; row += nw) {
        const int grp = row < MC ? 0 : 1 + ((row - MC) >> 10);
        const float* md = mod + (size_t)(grp * 4) * 6144;
        const float* x = row < MC ? p.in[0] + (size_t)row * 1024 : p.in[1] + (size_t)(row - MC) * 1024;
        f32x4 v[4]; float ss = 0.f;
#pragma unroll
        for (int j = 0; j < 4; ++j) { v[j] = __builtin_nontemporal_load((const f32x4*)(x + j * 256 + lane * 4)); ss += v[j][0] * v[j][0] + v[j][1] * v[j][1] + v[j][2] * v[j][2] + v[j][3] * v[j][3]; }
        ss = wave_sum(ss);
        if (lane == 0) rss[row] = ss;
#pragma unroll
        for (int j = 0; j < 4; ++j) { const int c = j * 256 + lane * 4;
            const f32x4 g4 = *(const f32x4*)(gw + c), sc = *(const f32x4*)(md + 1024 + c);
            const f32x4 o = v[j] * g4 * (1.f + sc);
            u32x2 w; w.x = pk(o[0], o[1]); w.y = pk(o[2], o[3]);
            *(u32x2*)(H + (size_t)row * 1024 + c) = w; }
    }
    bias_in(p, 0, wave, nw);
}

DI float log_sigmoid_f(float x) { return fminf(x, 0.f) - __logf(1.f + __expf(-fabsf(x))); }
DI void phase_ab_prep(const P& p, int i) {
    const bf16_t* proj = (const bf16_t*)(p.ws + W_PROJ);
    bf16_t* cqn = (bf16_t*)(p.ws + W_CQN); bf16_t* ckvn = (bf16_t*)(p.ws + W_CKVN); float* la = (float*)(p.ws + W_LA);
    const float* qng = p.in[20] + i * 384; const float* kvg = p.in[22] + i * 256;
    const float* aw2 = p.in[17] + (size_t)i * 2 * 16 * 256; const float* ab = p.in[18] + i * 2 * 256;
    const int tid_ = tid_o(); const int wave = bid_o() * 8 + (tid_ >> 6), nw = gridDim.x * 8, lane = tid_ & 63;
    for (int row = wave; row < MKV; row += nw) {
        if (row >= M) {
            const int cr = row - M, b = cr >> 9, pos = cr & 511;
            const f32x4 v = *(const f32x4*)(p.in[3] + ((size_t)(b * 2 + i) * 512 + pos) * 256 + lane * 4);
            u32x2 w; w.x = pk(v[0], v[1]); w.y = pk(v[2], v[3]);
            *(u32x2*)(ckvn + (size_t)row * 256 + lane * 4) = w;
            continue;
        }
        const bf16_t* pr = proj + (size_t)row * 2304;
        const bool ctx = row < MC; const int b = row >> 8, t = row & 255;
        {
            const unsigned* s = (const unsigned*)(pr + 1568 + lane * 6);
            const unsigned u0 = s[0], u1 = s[1], u2 = s[2];
            float x[6] = {bflo(u0), bfhi(u0), bflo(u1), bfhi(u1), bflo(u2), bfhi(u2)};
            float ss = 0.f;
#pragma unroll
            for (int j = 0; j < 6; ++j) ss += x[j] * x[j];
            ss = wave_sum(ss);
            const float rstd = rsqrtf(ss * (1.f / 384.f) + EPS);
#pragma unroll
            for (int j = 0; j < 6; ++j) x[j] *= rstd * qng[lane * 6 + j];
            unsigned* d = (unsigned*)(cqn + (size_t)row * 384 + lane * 6);
            d[0] = pk(x[0], x[1]); d[1] = pk(x[2], x[3]); d[2] = pk(x[4], x[5]);
        }
        {
            const u32x2 u = *(const u32x2*)(pr + 1952 + lane * 4);
            f32x4 x = {bflo(u.x), bfhi(u.x), bflo(u.y), bfhi(u.y)};
            float ss = wave_sum(x[0] * x[0] + x[1] * x[1] + x[2] * x[2] + x[3] * x[3]);
            const float rstd = rsqrtf(ss * (1.f / 256.f) + EPS);
            x = x * rstd * *(const f32x4*)(kvg + lane * 4);
            u32x2 w; w.x = pk(x[0], x[1]); w.y = pk(x[2], x[3]);
            *(u32x2*)(ckvn + (size_t)row * 256 + lane * 4) = w;
            if (ctx) __builtin_nontemporal_store(x, (f32x4*)(p.out + O_CKV + ((size_t)(b * 2 + i) * 256 + t) * 256 + lane * 4));
        }
        if (ctx && lane < 32) p.out[O_KPE + ((size_t)(b * 2 + i) * 256 + t) * 32 + lane] = bf2f(pr[2208 + lane]);
        {
            const float alo = bf2f(pr[1536 + (lane & 31)]);
#pragma unroll
            for (int z = 0; z < 2; ++z) {
                f32x4 acc = *(const f32x4*)(ab + z * 256 + lane * 4);
#pragma unroll
                for (int r = 0; r < 16; ++r) { const float a = __shfl(alo, z * 16 + r); acc += a * *(const f32x4*)(aw2 + (size_t)(z * 16 + r) * 256 + lane * 4); }
                f32x4 o;
#pragma unroll
                for (int j = 0; j < 4; ++j) o[j] = log_sigmoid_f(acc[j]) * (1.f / 16.f);
                *(f32x4*)(la + ((size_t)z * M + row) * 256 + lane * 4) = o;
            }
        }
    }
}

DI void vt_flush(const bf16_t* vst, int stride, int ncols, int tid, bf16_t* Vt, size_t base, int S, int spos0) {
    __syncthreads();
    if (tid < ncols) { const int hh = tid >> 6, dv = tid & 63; const bf16_t* sp = vst + tid;
        u32x4 o;
        o.x = (unsigned)sp[0] | ((unsigned)sp[stride] << 16); o.y = (unsigned)sp[2 * stride] | ((unsigned)sp[3 * stride] << 16);
        o.z = (unsigned)sp[4 * stride] | ((unsigned)sp[5 * stride] << 16); o.w = (unsigned)sp[6 * stride] | ((unsigned)sp[7 * stride] << 16);
        *(u32x4*)(Vt + base + ((size_t)hh * S) * 64 + (size_t)dv * S + spos0) = o; }
    __syncthreads();
}

constexpr float L2_THETA = 13.287712379549449f;
DI void phase_mla_prep(const P& p, int i, int vb, int nvb, char* shm) {
    const bf16_t* proj = (const bf16_t*)(p.ws + W_PROJ); const bf16_t* qm = (const bf16_t*)(p.ws + W_QM); const bf16_t* kvm = (const bf16_t*)(p.ws + W_KVM);
    bf16_t* Qp = (bf16_t*)(p.ws + W_QP); bf16_t* Kp = (bf16_t*)(p.ws + W_KP); bf16_t* Vt = (bf16_t*)(p.ws + W_VT);
    const float* qng = p.in[24] + i * 96; const float* kng = p.in[25] + i * 96;
    const int tid_ = tid_o(); const int wave = vb * 8 + (tid_ >> 6), nw = nvb * 8, lane = tid_ & 63;
    const int h = lane >> 3, hl = lane & 7, a = hl >> 2, f0 = (hl & 3) * 2;
    const int d1 = 64 + a * 16 + f0, d2 = d1 + 8;
    const float QS = 0.10206207261596577f * LOG2E;
    for (int row = wave; row < MKV; row += nw) {
        const bool is_lat = row >= MC && row < M, is_cache = row >= M;
        int t = 0, lb = 0, cpos = 0;
        if (is_lat) { t = (row - MC) & 1023; lb = (row - MC) >> 10; }
        if (is_cache) { lb = (row - M) >> 9; cpos = (row - M) & 511; }
        float cs[2] = {1.f, 1.f}, sn[2] = {0.f, 0.f};
        if (is_lat) { const float pos = (float)(a == 0 ? (t >> 6) : (t & 63));
#pragma unroll
            for (int e = 0; e < 2; ++e) { const float ang = pos * exp2f(-(float)(f0 + e) * (L2_THETA / 8.f)); cs[e] = __cosf(ang); sn[e] = __sinf(ang); } }
        int rb, S, spos, drow;
        if (is_cache) { rb = MC + lb * 1536; S = 1536; spos = cpos; }
        else if (is_lat) { rb = MC + lb * 1536; S = 1536; spos = 512 + t; }
        else { rb = row & ~255; S = 256; spos = row & 255; }
        drow = rb + spos;
        {
            const bf16_t* kv = kvm + (size_t)row * 1024 + h * 128;
            const u32x4 kn = *(const u32x4*)(kv + hl * 8);
            float x[8] = {bflo(kn.x), bfhi(kn.x), bflo(kn.y), bfhi(kn.y), bflo(kn.z), bfhi(kn.z), bflo(kn.w), bfhi(kn.w)};
            float r1[2], r2[2];
            if (!is_cache) { const bf16_t* kp = proj + (size_t)row * 2304 + 2208; const unsigned u1 = *(const unsigned*)(kp + a * 16 + f0), u2 = *(const unsigned*)(kp + a * 16 + 8 + f0);
                r1[0] = bflo(u1); r1[1] = bfhi(u1); r2[0] = bflo(u2); r2[1] = bfhi(u2); }
            else { const float* kp = p.in[4] + ((size_t)(lb * 2 + i) * 512 + cpos) * 32; r1[0] = kp[a * 16 + f0]; r1[1] = kp[a * 16 + f0 + 1]; r2[0] = kp[a * 16 + 8 + f0]; r2[1] = kp[a * 16 + 8 + f0 + 1]; }
            float ss = r1[0] * r1[0] + r1[1] * r1[1] + r2[0] * r2[0] + r2[1] * r2[1];
#pragma unroll
            for (int j = 0; j < 8; ++j) ss += x[j] * x[j];
            ss += __shfl_xor(ss, 1); ss += __shfl_xor(ss, 2); ss += __shfl_xor(ss, 4);
            const float rstd = rsqrtf(ss * (1.f / 96.f) + EPS);
#pragma unroll
            for (int j = 0; j < 8; ++j) x[j] *= rstd * kng[hl * 8 + j];
            float o1[2], o2[2];
#pragma unroll
            for (int e = 0; e < 2; ++e) { const float y1 = r1[e] * rstd * kng[d1 + e], y2 = r2[e] * rstd * kng[d2 + e]; o1[e] = y1 * cs[e] - y2 * sn[e]; o2[e] = y1 * sn[e] + y2 * cs[e]; }
            bf16_t* kd = Kp + (size_t)drow * 768 + h * 96;
            u32x4 w; w.x = pk(x[0], x[1]); w.y = pk(x[2], x[3]); w.z = pk(x[4], x[5]); w.w = pk(x[6], x[7]);
            *(u32x4*)(kd + hl * 8) = w;
            *(unsigned*)(kd + d1) = pk(o1[0], o1[1]); *(unsigned*)(kd + d2) = pk(o2[0], o2[1]);
            const u32x4 vv = *(const u32x4*)(kv + 64 + hl * 8);
            bf16_t* vst = (bf16_t*)shm; const int wv = tid_ >> 6;
            *(u32x4*)(vst + wv * 520 + h * 64 + hl * 8) = vv;
            vt_flush(vst, 520, 512, tid_, Vt, (size_t)rb * 8 * 64, S, spos - wv);
        }
        if (row < M) {
            const bf16_t* q = qm + (size_t)row * 768 + h * 96;
            const u32x4 qn = *(const u32x4*)(q + hl * 8);
            float x[8] = {bflo(qn.x), bfhi(qn.x), bflo(qn.y), bfhi(qn.y), bflo(qn.z), bfhi(qn.z), bflo(qn.w), bfhi(qn.w)};
            const unsigned u1 = *(const unsigned*)(q + d1), u2 = *(const unsigned*)(q + d2);
            float r1[2] = {bflo(u1), bfhi(u1)}, r2[2] = {bflo(u2), bfhi(u2)};
            float ss = r1[0] * r1[0] + r1[1] * r1[1] + r2[0] * r2[0] + r2[1] * r2[1];
#pragma unroll
            for (int j = 0; j < 8; ++j) ss += x[j] * x[j];
            ss += __shfl_xor(ss, 1); ss += __shfl_xor(ss, 2); ss += __shfl_xor(ss, 4);
            const float rstd = rsqrtf(ss * (1.f / 96.f) + EPS) * QS;
#pragma unroll
            for (int j = 0; j < 8; ++j) x[j] *= rstd * qng[hl * 8 + j];
            float o1[2], o2[2];
#pragma unroll
            for (int e = 0; e < 2; ++e) { const float y1 = r1[e] * rstd * qng[d1 + e], y2 = r2[e] * rstd * qng[d2 + e]; o1[e] = y1 * cs[e] - y2 * sn[e]; o2[e] = y1 * sn[e] + y2 * cs[e]; }
            bf16_t* qd = Qp + (size_t)row * 768 + h * 96;
            u32x4 w; w.x = pk(x[0], x[1]); w.y = pk(x[2], x[3]); w.z = pk(x[4], x[5]); w.w = pk(x[6], x[7]);
            *(u32x4*)(qd + hl * 8) = w;
            *(unsigned*)(qd + d1) = pk(o1[0], o1[1]); *(unsigned*)(qd + d2) = pk(o2[0], o2[1]);
        }
    }
}

DI void phase_gqa_prep(const P& p, int i, char* shm) {
    const bf16_t* proj = (const bf16_t*)(p.ws + W_PROJ);
    bf16_t* Qp = (bf16_t*)(p.ws + W_QP); bf16_t* Kp = (bf16_t*)(p.ws + W_KP); bf16_t* Vt = (bf16_t*)(p.ws + W_VT);
    const float* qng = p.in[28] + i * 64; const float* kng = p.in[29] + i * 64;
    const int tid_ = tid_o(); const int wave = bid_o() * 8 + (tid_ >> 6), nw = gridDim.x * 8, lane = tid_ & 63;
    const int h = lane >> 2, hl = lane & 3, a = hl >> 1, f0 = (hl & 1) * 8;
    const int d1 = a * 32 + f0, d2 = d1 + 16;
    const float QS = 0.125f * LOG2E;
    for (int row = wave; row < MKV; row += nw) {
        if (row >= M) {
            const int cr = row - M, lb = cr >> 9, pos = cr & 511, rb = MC + lb * 1536;
            const size_t so = ((size_t)(lb * 2 + i) * 512 + pos) * 256 + lane * 4;
            const f32x4 kx = *(const f32x4*)(p.in[6] + so), vx = *(const f32x4*)(p.in[7] + so);
            u32x2 w; w.x = pk(kx[0], kx[1]); w.y = pk(kx[2], kx[3]);
            *(u32x2*)(Kp + (size_t)(rb + pos) * 256 + lane * 4) = w;
            bf16_t* vst = (bf16_t*)shm; const int wv = tid_ >> 6;
            u32x2 vw; vw.x = pk(vx[0], vx[1]); vw.y = pk(vx[2], vx[3]);
            *(u32x2*)(vst + wv * 264 + lane * 4) = vw;
            vt_flush(vst, 264, 256, tid_, Vt, (size_t)rb * 4 * 64, 1536, pos - wv);
            continue;
        }
        const bool is_lat = row >= MC;
        int t = 0, lb = 0;
        if (is_lat) { t = (row - MC) & 1023; lb = (row - MC) >> 10; }
        float cs[8], sn[8];
#pragma unroll
        for (int e = 0; e < 8; ++e) { cs[e] = 1.f; sn[e] = 0.f; }
        if (is_lat) { const float pos = (float)(a == 0 ? (t >> 6) : (t & 63));
#pragma unroll
            for (int e = 0; e < 8; ++e) { const float ang = pos * exp2f(-(float)(f0 + e) * (L2_THETA / 16.f)); cs[e] = __cosf(ang); sn[e] = __sinf(ang); } }
        int rb, S, spos;
        if (is_lat) { rb = MC + lb * 1536; S = 1536; spos = 512 + t; } else { rb = row & ~255; S = 256; spos = row & 255; }
        const bf16_t* pr = proj + (size_t)row * 1536;
        {
            const u32x4 ua = *(const u32x4*)(pr + h * 64 + d1), ub = *(const u32x4*)(pr + h * 64 + d2);
            float x1[8] = {bflo(ua.x), bfhi(ua.x), bflo(ua.y), bfhi(ua.y), bflo(ua.z), bfhi(ua.z), bflo(ua.w), bfhi(ua.w)};
            float x2[8] = {bflo(ub.x), bfhi(ub.x), bflo(ub.y), bfhi(ub.y), bflo(ub.z), bfhi(ub.z), bflo(ub.w), bfhi(ub.w)};
            float ss = 0.f;
#pragma unroll
            for (int e = 0; e < 8; ++e) ss += x1[e] * x1[e] + x2[e] * x2[e];
            ss += __shfl_xor(ss, 1); ss += __shfl_xor(ss, 2);
            const float rstd = rsqrtf(ss * (1.f / 64.f) + EPS) * QS;
            float o1[8], o2[8];
#pragma unroll
            for (int e = 0; e < 8; ++e) { const float y1 = x1[e] * rstd * qng[d1 + e], y2 = x2[e] * rstd * qng[d2 + e]; o1[e] = y1 * cs[e] - y2 * sn[e]; o2[e] = y1 * sn[e] + y2 * cs[e]; }
            bf16_t* qd = Qp + (size_t)row * 1024 + h * 64;
            u32x4 w1, w2; w1.x = pk(o1[0], o1[1]); w1.y = pk(o1[2], o1[3]); w1.z = pk(o1[4], o1[5]); w1.w = pk(o1[6], o1[7]);
            w2.x = pk(o2[0], o2[1]); w2.y = pk(o2[2], o2[3]); w2.z = pk(o2[4], o2[5]); w2.w = pk(o2[6], o2[7]);
            *(u32x4*)(qd + d1) = w1; *(u32x4*)(qd + d2) = w2;
        }
        {
            const int hk = h & 3;
            const u32x4 ua = *(const u32x4*)(pr + 1024 + hk * 64 + d1), ub = *(const u32x4*)(pr + 1024 + hk * 64 + d2);
            float x1[8] = {bflo(ua.x), bfhi(ua.x), bflo(ua.y), bfhi(ua.y), bflo(ua.z), bfhi(ua.z), bflo(ua.w), bfhi(ua.w)};
            float x2[8] = {bflo(ub.x), bfhi(ub.x), bflo(ub.y), bfhi(ub.y), bflo(ub.z), bfhi(ub.z), bflo(ub.w), bfhi(ub.w)};
            float ss = 0.f;
#pragma unroll
            for (int e = 0; e < 8; ++e) ss += x1[e] * x1[e] + x2[e] * x2[e];
            ss += __shfl_xor(ss, 1); ss += __shfl_xor(ss, 2);
            const float rstd = rsqrtf(ss * (1.f / 64.f) + EPS);
            float o1[8], o2[8];
#pragma unroll
            for (int e = 0; e < 8; ++e) { const float y1 = x1[e] * rstd * kng[d1 + e], y2 = x2[e] * rstd * kng[d2 + e]; x1[e] = y1; x2[e] = y2; o1[e] = y1 * cs[e] - y2 * sn[e]; o2[e] = y1 * sn[e] + y2 * cs[e]; }
            if (lane < 16) {
                if (!is_lat) { float* kd = p.out + O_K + ((size_t)((row >> 8) * 2 + i) * 256 + (row & 255)) * 256 + hk * 64;
                    __builtin_nontemporal_store((f32x4){x1[0], x1[1], x1[2], x1[3]}, (f32x4*)(kd + d1)); __builtin_nontemporal_store((f32x4){x1[4], x1[5], x1[6], x1[7]}, (f32x4*)(kd + d1 + 4));
                    __builtin_nontemporal_store((f32x4){x2[0], x2[1], x2[2], x2[3]}, (f32x4*)(kd + d2)); __builtin_nontemporal_store((f32x4){x2[4], x2[5], x2[6], x2[7]}, (f32x4*)(kd + d2 + 4)); }
                bf16_t* kd = Kp + (size_t)(rb + spos) * 256 + hk * 64;
                u32x4 w1, w2; w1.x = pk(o1[0], o1[1]); w1.y = pk(o1[2], o1[3]); w1.z = pk(o1[4], o1[5]); w1.w = pk(o1[6], o1[7]);
                w2.x = pk(o2[0], o2[1]); w2.y = pk(o2[2], o2[3]); w2.z = pk(o2[4], o2[5]); w2.w = pk(o2[6], o2[7]);
                *(u32x4*)(kd + d1) = w1; *(u32x4*)(kd + d2) = w2;
            }
        }
        {
            const u32x2 u = *(const u32x2*)(pr + 1280 + lane * 4);
            if (!is_lat) __builtin_nontemporal_store((f32x4){bflo(u.x), bfhi(u.x), bflo(u.y), bfhi(u.y)}, (f32x4*)(p.out + O_V + ((size_t)((row >> 8) * 2 + i) * 256 + (row & 255)) * 256 + lane * 4));
            bf16_t* vst = (bf16_t*)shm; const int wv = tid_ >> 6;
            *(u32x2*)(vst + wv * 264 + lane * 4) = u;
            vt_flush(vst, 264, 256, tid_, Vt, (size_t)rb * 4 * 64, S, spos - wv);
        }
    }
}

template <int DQK, int HQ, int HKV, int COLOFF>
DI void phase_attn(const P& p) {
    constexpr int NK = DQK / 32, KS = HKV * DQK, QSTR = HQ * DQK;
    const bf16_t* Qp = (const bf16_t*)(p.ws + W_QP); const bf16_t* Kp = (const bf16_t*)(p.ws + W_KP); const bf16_t* Vt = (const bf16_t*)(p.ws + W_VT);
    bf16_t* mix = (bf16_t*)(p.ws + W_MIX);
    const int tid_ = tid_o(); const int wave = bid_o() * 8 + (tid_ >> 6), nw = gridDim.x * 8, lane = tid_ & 63, fr = lane & 15, fq = lane >> 4;
    constexpr int NQT = M / 16;
    for (int it = wave; it < NQT * HQ; it += nw) {
        const int qt = NQT - 1 - it / HQ, h = it % HQ, row0 = qt * 16;
        int rb, S;
        if (row0 < MC) { rb = row0 & ~255; S = 256; } else { rb = MC + ((row0 - MC) >> 10) * 1536; S = 1536; }
        const int hk = h / (HQ / HKV);
        const bf16_t* Kb = Kp + (size_t)rb * KS + hk * DQK + (size_t)fr * KS + fq * 8;
        const bf16_t* Vb = Vt + ((size_t)rb * HKV + (size_t)hk * S) * 64 + (size_t)fr * S + fq * 4;
        bf16x8 qf[NK];
#pragma unroll
        for (int ks = 0; ks < NK; ++ks) qf[ks] = *(const bf16x8*)(Qp + (size_t)(row0 + fr) * QSTR + h * DQK + ks * 32 + fq * 8);
        f32x4 o[4];
#pragma unroll
        for (int tq = 0; tq < 4; ++tq) o[tq] = (f32x4){0.f, 0.f, 0.f, 0.f};
        float mrun = -1e30f, lsum = 0.f;
        for (int k0 = 0; k0 < S; k0 += 32) {
            f32x4 s0 = {0.f, 0.f, 0.f, 0.f}, s1 = s0;
#pragma unroll
            for (int ks = 0; ks < NK; ++ks) {
                const bf16x8 ka = *(const bf16x8*)(Kb + (size_t)k0 * KS + ks * 32), kb2 = *(const bf16x8*)(Kb + (size_t)(k0 + 16) * KS + ks * 32);
                s0 = mfma16(ka, qf[ks], s0); s1 = mfma16(kb2, qf[ks], s1);
            }
            s16x4 va[4], vb[4];
#pragma unroll
            for (int tq = 0; tq < 4; ++tq) { va[tq] = *(const s16x4*)(Vb + (size_t)(tq * 16) * S + k0); vb[tq] = *(const s16x4*)(Vb + (size_t)(tq * 16) * S + k0 + 16); }
            float mx = fmaxf(fmaxf(fmaxf(s0[0], s0[1]), fmaxf(s0[2], s0[3])), fmaxf(fmaxf(s1[0], s1[1]), fmaxf(s1[2], s1[3])));
            mx = fmaxf(mx, __shfl_xor(mx, 16)); mx = fmaxf(mx, __shfl_xor(mx, 32));
            const float mn = fmaxf(mrun, mx), alpha = exp2f(mrun - mn); mrun = mn;
            float p0[4], p1[4], ps = 0.f;
#pragma unroll
            for (int j = 0; j < 4; ++j) { p0[j] = exp2f(s0[j] - mn); p1[j] = exp2f(s1[j] - mn); ps += p0[j] + p1[j]; }
            lsum = lsum * alpha + ps;
            u32x4 pw; pw.x = pk(p0[0], p0[1]); pw.y = pk(p0[2], p0[3]); pw.z = pk(p1[0], p1[1]); pw.w = pk(p1[2], p1[3]);
            const bf16x8 pf = __builtin_bit_cast(bf16x8, pw);
#pragma unroll
            for (int tq = 0; tq < 4; ++tq) {
                const bf16x8 vf = __builtin_shufflevector(va[tq], vb[tq], 0, 1, 2, 3, 4, 5, 6, 7);
                o[tq] = mfma16(vf, pf, o[tq] * alpha);
            }
        }
        lsum += __shfl_xor(lsum, 16); lsum += __shfl_xor(lsum, 32);
        const float inv = 1.f / lsum;
        bf16_t* od = mix + (size_t)(row0 + fr) * 1024 + COLOFF + h * 64 + fq * 4;
#pragma unroll
        for (int tq = 0; tq < 4; ++tq) { u32x2 w; w.x = pk(o[tq][0] * inv, o[tq][1] * inv); w.y = pk(o[tq][2] * inv, o[tq][3] * inv); *(u32x2*)(od + tq * 16) = w; }
    }
}


template <int DQK, int HQ, int HKV, int COLOFF>
DI void phase_attn2(const P& p, char* shm, int bshift) {
    constexpr int NK = DQK / 32, KS = HKV * DQK, QSTR = HQ * DQK, GQ = HQ / HKV, RB = (8 / GQ) * 32;
    constexpr int KROW = DQK * 2 + 16, VROW = 144, KBUF = 64 * KROW, VBUF = 64 * VROW, KCH = DQK / 8, NKCH = 64 * KCH;
    constexpr int NL = 2 * HKV * (1024 / RB), NC = 32 * HKV * (256 / RB);
    const bf16_t* Qp = (const bf16_t*)(p.ws + W_QP); const bf16_t* Kp = (const bf16_t*)(p.ws + W_KP); const bf16_t* Vt = (const bf16_t*)(p.ws + W_VT);
    bf16_t* mix = (bf16_t*)(p.ws + W_MIX);
    const int tid = tid_o(), w = tid >> 6, lane = tid & 63, fr = lane & 15, fq = lane >> 4;
    const int G = gridDim.x, vb = (bid_o() + bshift) % G;
    for (int kit = 0;; ++kit) {
        int item;
        if (G > NL) { if (vb < NL) { if (kit > 0) break; item = vb; } else { const int c = (vb - NL) + kit * (G - NL); if (c >= NC) break; item = NL + c; } }
        else { item = vb + kit * G; if (item >= NL + NC) break; }
        int rb, S, qrow0, hk;
        if (item < NL) { constexpr int QB = 1024 / RB; const int lb = item / (HKV * QB), rem = item % (HKV * QB); hk = rem / QB; rb = MC + lb * 1536; S = 1536; qrow0 = MC + lb * 1024 + (rem % QB) * RB; }
        else { constexpr int QB = 256 / RB; const int c = item - NL, b = c / (HKV * QB), rem = c % (HKV * QB); hk = rem / QB; rb = b * 256; S = 256; qrow0 = b * 256 + (rem % QB) * RB; }
        const int hq = hk * GQ + (w % GQ), q0 = qrow0 + (w / GQ) * 32;
        bf16x8 qf[2][NK];
#pragma unroll
        for (int qi = 0; qi < 2; ++qi)
#pragma unroll
            for (int ks = 0; ks < NK; ++ks) qf[qi][ks] = *(const bf16x8*)(Qp + (size_t)(q0 + qi * 16 + fr) * QSTR + hq * DQK + ks * 32 + fq * 8);
        f32x4 o[4][2];
#pragma unroll
        for (int tq = 0; tq < 4; ++tq) { o[tq][0] = (f32x4){0.f, 0.f, 0.f, 0.f}; o[tq][1] = o[tq][0]; }
        float mrun[2] = {-1e30f, -1e30f}, lsum[2] = {0.f, 0.f};
        const int kr0 = tid / KCH, kc0 = tid % KCH, kr1 = (tid + 512) / KCH, kc1 = (tid + 512) % KCH;
        const bool has1 = (tid + 512) < NKCH;
        const bf16_t* kg0 = Kp + (size_t)(rb + kr0) * KS + hk * DQK + kc0 * 8;
        const bf16_t* kg1 = Kp + (size_t)(rb + (has1 ? kr1 : 0)) * KS + hk * DQK + kc1 * 8;
        const int kl0 = kr0 * KROW + kc0 * 16, kl1 = kr1 * KROW + kc1 * 16;
        const int vr = tid >> 3, vc = tid & 7;
        const bf16_t* vg = Vt + ((size_t)rb * HKV + (size_t)hk * S) * 64 + (size_t)vr * S + vc * 8;
        const int vl = 2 * KBUF + vr * VROW + vc * 16;
        const int nseg = S / 256;
        u32x4 ks0, ks1 = {0u, 0u, 0u, 0u}, vs;
        for (int seg = 0; seg < nseg; ++seg) {
        const bf16_t* kg0s = kg0 + (size_t)seg * 256 * KS; const bf16_t* kg1s = kg1 + (size_t)seg * 256 * KS; const bf16_t* vgs = vg + seg * 256;
        ks0 = *(const u32x4*)kg0s; if (has1) ks1 = *(const u32x4*)kg1s; vs = *(const u32x4*)vgs;
        *(u32x4*)(shm + kl0) = ks0; if (has1) *(u32x4*)(shm + kl1) = ks1; *(u32x4*)(shm + vl) = vs;
        __syncthreads();
#pragma unroll 1
        for (int t = 0; t < 4; ++t) {
            const int cur = t & 1;
            if (t + 1 < 4) { const size_t ko = (size_t)(t + 1) * 64 * KS; ks0 = *(const u32x4*)(kg0s + ko); if (has1) ks1 = *(const u32x4*)(kg1s + ko); vs = *(const u32x4*)(vgs + (t + 1) * 64); }
            const char* kb = shm + cur * KBUF; const char* vbp = shm + 2 * KBUF + cur * VBUF;
            f32x4 s[4][2];
#pragma unroll
            for (int kt = 0; kt < 4; ++kt) {
                bf16x8 kf[NK];
#pragma unroll
                for (int ks = 0; ks < NK; ++ks) kf[ks] = *(const bf16x8*)(kb + (kt * 16 + fr) * KROW + ks * 64 + fq * 16);
#pragma unroll
                for (int qi = 0; qi < 2; ++qi) { f32x4 a = {0.f, 0.f, 0.f, 0.f};
#pragma unroll
                    for (int ks = 0; ks < NK; ++ks) a = mfma16(kf[ks], qf[qi][ks], a);
                    s[kt][qi] = a; }
            }
            bf16x8 pf[2][2];
#pragma unroll
            for (int qi = 0; qi < 2; ++qi) {
                float mx = -1e30f;
#pragma unroll
                for (int kt = 0; kt < 4; ++kt) mx = fmaxf(mx, fmaxf(fmaxf(s[kt][qi][0], s[kt][qi][1]), fmaxf(s[kt][qi][2], s[kt][qi][3])));
                mx = fmaxf(mx, __shfl_xor(mx, 16)); mx = fmaxf(mx, __shfl_xor(mx, 32));
                const float mn = fmaxf(mrun[qi], mx), alpha = __builtin_amdgcn_exp2f(mrun[qi] - mn); mrun[qi] = mn;
                float ps = 0.f;
#pragma unroll
                for (int kt = 0; kt < 4; ++kt)
#pragma unroll
                    for (int r = 0; r < 4; ++r) { const float e = __builtin_amdgcn_exp2f(s[kt][qi][r] - mn); s[kt][qi][r] = e; ps += e; }
                lsum[qi] = lsum[qi] * alpha + ps;
#pragma unroll
                for (int kk = 0; kk < 2; ++kk) { u32x4 pw; pw.x = pk(s[2 * kk][qi][0], s[2 * kk][qi][1]); pw.y = pk(s[2 * kk][qi][2], s[2 * kk][qi][3]);
                    pw.z = pk(s[2 * kk + 1][qi][0], s[2 * kk + 1][qi][1]); pw.w = pk(s[2 * kk + 1][qi][2], s[2 * kk + 1][qi][3]); pf[qi][kk] = __builtin_bit_cast(bf16x8, pw); }
#pragma unroll
                for (int tq = 0; tq < 4; ++tq) o[tq][qi] = o[tq][qi] * alpha;
            }
#pragma unroll
            for (int tq = 0; tq < 4; ++tq)
#pragma unroll
                for (int kk = 0; kk < 2; ++kk) {
                    const s16x4 va = *(const s16x4*)(vbp + (tq * 16 + fr) * VROW + kk * 64 + fq * 8), vb2 = *(const s16x4*)(vbp + (tq * 16 + fr) * VROW + kk * 64 + 32 + fq * 8);
                    const bf16x8 vf = __builtin_shufflevector(va, vb2, 0, 1, 2, 3, 4, 5, 6, 7);
                    o[tq][0] = mfma16(vf, pf[0][kk], o[tq][0]); o[tq][1] = mfma16(vf, pf[1][kk], o[tq][1]);
                }
            if (t + 1 < 4) { const int nb = cur ^ 1; *(u32x4*)(shm + nb * KBUF + kl0) = ks0; if (has1) *(u32x4*)(shm + nb * KBUF + kl1) = ks1; *(u32x4*)(shm + nb * VBUF + vl) = vs; }
            __syncthreads();
        }
        }
#pragma unroll
        for (int qi = 0; qi < 2; ++qi) {
            float l = lsum[qi]; l += __shfl_xor(l, 16); l += __shfl_xor(l, 32);
            const float inv = 1.f / l;
            bf16_t* od = mix + (size_t)(q0 + qi * 16 + fr) * 1024 + COLOFF + hq * 64 + fq * 4;
#pragma unroll
            for (int tq = 0; tq < 4; ++tq) { u32x2 wv; wv.x = pk(o[tq][qi][0] * inv, o[tq][qi][1] * inv); wv.y = pk(o[tq][qi][2] * inv, o[tq][qi][3] * inv); *(u32x2*)(od + tq * 16) = wv; }
        }
    }
}

DI void phase_gla(const P& p, int i, char* shm, int part) {
    float* bL = (float*)shm;
    bf16_t* qloc = (bf16_t*)(shm + 16640);
    bf16_t* kloc = qloc + 64 * 72;
    bf16_t* qin = kloc + 64 * 72;
    bf16_t* kstT = qin + 64 * 72;
    bf16_t* Am = kstT + 64 * 72;
    bf16_t* vT = Am + 64 * 72;
    float* segs = (float*)(vT + 128 * 72);
    const bf16_t* proj = (const bf16_t*)(p.ws + W_PROJ); const float* la = (const float*)(p.ws + W_LA); float* odir = (float*)(p.ws + W_ODIR);
    const int tid = tid_o(), w = tid >> 6, lane = tid & 63, fr = lane & 15, fq = lane >> 4;
    const int G = gridDim.x;
    const bool split = (G == 256);
    float* gst = (float*)(p.ws + W_GST);
    if (part < 2 && !split) return;
    const int nrounds = part < 2 ? 1 : ((G == 256) ? 2 : (272 + G - 1) / G);
    for (int rnd = 0; rnd < nrounds; ++rnd) {
        int j;
        const int bidg = bid_o();
        if (part < 2) j = bidg < 16 ? bidg : -1;
        else if (G == 256) {
            if (rnd == 0) j = (bidg >= 128 && bidg < 192) ? -1 : bidg;
            else j = (bidg >= 16 && bidg < 32) ? 240 + bidg : ((bidg >= 96 && bidg < 128) ? bidg + 32 : ((bidg >= 32 && bidg < 64) ? bidg + 128 : -1));
        }
        else j = bidg + rnd * G;
        if (j < 0 || j >= 272) continue;
        int b, hd, dir, T, rowbase; bool ctx;
        if (j < 16) { ctx = false; b = j >> 3; hd = (j >> 1) & 3; dir = j & 1; T = 1024; rowbase = MC + b * 1024; }
        else { const int jj = j - 16; ctx = true; b = jj >> 3; hd = (jj >> 1) & 3; dir = jj & 1; T = 256; rowbase = b * 256; }
        f32x4 Sacc[4];
        const size_t sidx = ((size_t)((b * 2 + i) * 2 + dir) * 4 + hd) * 64 * 128;
#pragma unroll
        for (int dt = 0; dt < 4; ++dt) {
            if (ctx) Sacc[dt] = (f32x4){0.f, 0.f, 0.f, 0.f};
            else if (split && part > 0) Sacc[dt] = *(const f32x4*)(gst + ((size_t)j * 512 + tid) * 16 + dt * 4);
            else {
#pragma unroll
                for (int r = 0; r < 4; ++r) Sacc[dt][r] = p.in[5][sidx + (size_t)(dt * 16 + fq * 4 + r) * 128 + w * 16 + fr];
            }
        }
        const int nch = T / 64;
        const int c0 = (!ctx && split) ? (part == 0 ? 0 : (part == 1 ? 5 : 8)) : 0;
        const int c1 = (!ctx && split) ? (part == 0 ? 5 : (part == 1 ? 8 : 16)) : nch;
        const int ii = tid & 63, d8 = (tid >> 6) * 8, v16 = (tid >> 6) * 16;
        f32x4 nl0, nl1; u32x4 nqu, nku, nv0, nv1;
        {
            const int trow0 = dir == 0 ? c0 * 64 + ii : T - 1 - (c0 * 64 + ii); const size_t g0 = (size_t)rowbase + trow0;
            const float* lp = la + ((size_t)dir * M + g0) * 256 + hd * 64 + d8; nl0 = *(const f32x4*)lp; nl1 = *(const f32x4*)(lp + 4);
            const bf16_t* pr = proj + g0 * 2304 + hd * 64 + d8; nqu = *(const u32x4*)pr; nku = *(const u32x4*)(pr + 256);
            const bf16_t* pv = proj + g0 * 2304 + 512 + hd * 128 + v16; nv0 = *(const u32x4*)pv; nv1 = *(const u32x4*)(pv + 8);
        }
        for (int c = c0; c < c1; ++c) {
            const f32x4 l0 = nl0, l1 = nl1; const u32x4 qu = nqu, ku = nku, v0 = nv0, v1 = nv1;
            {
                float* bd = bL + ii * 65 + d8;
                bd[0] = l0[0]; bd[1] = l0[1]; bd[2] = l0[2]; bd[3] = l0[3]; bd[4] = l1[0]; bd[5] = l1[1]; bd[6] = l1[2]; bd[7] = l1[3];
            }
            if (c + 1 < c1) {
                const int trn = dir == 0 ? (c + 1) * 64 + ii : T - 1 - ((c + 1) * 64 + ii); const size_t gn = (size_t)rowbase + trn;
                const float* lp = la + ((size_t)dir * M + gn) * 256 + hd * 64 + d8; nl0 = *(const f32x4*)lp; nl1 = *(const f32x4*)(lp + 4);
                const bf16_t* pr = proj + gn * 2304 + hd * 64 + d8; nqu = *(const u32x4*)pr; nku = *(const u32x4*)(pr + 256);
                const bf16_t* pv = proj + gn * 2304 + 512 + hd * 128 + v16; nv0 = *(const u32x4*)pv; nv1 = *(const u32x4*)(pv + 8);
            }
            __syncthreads();
            {
                const int d = tid & 63, seg = tid >> 6;
                float loc[8]; float acc = 0.f;
#pragma unroll
                for (int r = 0; r < 8; ++r) { acc += bL[(seg * 8 + r) * 65 + d]; loc[r] = acc; }
                segs[seg * 64 + d] = acc;
                __syncthreads();
                float pre = 0.f;
#pragma unroll
                for (int s = 0; s < 8; ++s) pre += (s < seg) ? segs[s * 64 + d] : 0.f;
#pragma unroll
                for (int r = 0; r < 8; ++r) bL[(seg * 8 + r) * 65 + d] = pre + loc[r];
            }
            __syncthreads();
            {
                float qv[8] = {bflo(qu.x), bfhi(qu.x), bflo(qu.y), bfhi(qu.y), bflo(qu.z), bfhi(qu.z), bflo(qu.w), bfhi(qu.w)};
                float kv[8] = {bflo(ku.x), bfhi(ku.x), bflo(ku.y), bfhi(ku.y), bflo(ku.z), bfhi(ku.z), bflo(ku.w), bfhi(ku.w)};
                float ql[8], kl[8], qi[8];
#pragma unroll
                for (int e = 0; e < 8; ++e) {
                    const float bb = bL[ii * 65 + d8 + e], bref = bL[31 * 65 + d8 + e], blast = bL[63 * 65 + d8 + e];
                    const float q = qv[e] * 0.125f, k = kv[e];
                    ql[e] = q * __expf(bb - bref); kl[e] = k * __expf(bref - bb); qi[e] = q * __expf(bb);
                    kstT[(d8 + e) * 72 + ii] = f2bf(k * __expf(blast - bb));
                }
                u32x4 wq, wk, wi;
                wq.x = pk(ql[0], ql[1]); wq.y = pk(ql[2], ql[3]); wq.z = pk(ql[4], ql[5]); wq.w = pk(ql[6], ql[7]);
                wk.x = pk(kl[0], kl[1]); wk.y = pk(kl[2], kl[3]); wk.z = pk(kl[4], kl[5]); wk.w = pk(kl[6], kl[7]);
                wi.x = pk(qi[0], qi[1]); wi.y = pk(qi[2], qi[3]); wi.z = pk(qi[4], qi[5]); wi.w = pk(qi[6], qi[7]);
                *(u32x4*)(qloc + ii * 72 + d8) = wq; *(u32x4*)(kloc + ii * 72 + d8) = wk; *(u32x4*)(qin + ii * 72 + d8) = wi;
                bf16_t* vd = vT + v16 * 72 + ii;
                vd[0 * 72] = (bf16_t)(v0.x & 0xffff); vd[1 * 72] = (bf16_t)(v0.x >> 16); vd[2 * 72] = (bf16_t)(v0.y & 0xffff); vd[3 * 72] = (bf16_t)(v0.y >> 16);
                vd[4 * 72] = (bf16_t)(v0.z & 0xffff); vd[5 * 72] = (bf16_t)(v0.z >> 16); vd[6 * 72] = (bf16_t)(v0.w & 0xffff); vd[7 * 72] = (bf16_t)(v0.w >> 16);
                vd[8 * 72] = (bf16_t)(v1.x & 0xffff); vd[9 * 72] = (bf16_t)(v1.x >> 16); vd[10 * 72] = (bf16_t)(v1.y & 0xffff); vd[11 * 72] = (bf16_t)(v1.y >> 16);
                vd[12 * 72] = (bf16_t)(v1.z & 0xffff); vd[13 * 72] = (bf16_t)(v1.z >> 16); vd[14 * 72] = (bf16_t)(v1.w & 0xffff); vd[15 * 72] = (bf16_t)(v1.w >> 16);
            }
            __syncthreads();
            {
                const int it = w >> 1;
#pragma unroll
                for (int u = 0; u < 2; ++u) {
                    const int st = (w & 1) * 2 + u;
                    f32x4 a = {0.f, 0.f, 0.f, 0.f};
                    if (st <= it) {
#pragma unroll
                        for (int ks = 0; ks < 2; ++ks) {
                            const bf16x8 aq = *(const bf16x8*)(qloc + (it * 16 + fr) * 72 + ks * 32 + fq * 8);
                            const bf16x8 bk = *(const bf16x8*)(kloc + (st * 16 + fr) * 72 + ks * 32 + fq * 8);
                            a = mfma16(aq, bk, a);
                        }
                    }
#pragma unroll
                    for (int r = 0; r < 4; ++r) { const int irow = it * 16 + fq * 4 + r, s = st * 16 + fr; Am[irow * 72 + s] = f2bf(s <= irow ? a[r] : 0.f); }
                }
            }
            __syncthreads();
            {
                bf16x8 vf[2], sb[2];
#pragma unroll
                for (int ks = 0; ks < 2; ++ks) {
                    vf[ks] = *(const bf16x8*)(vT + (w * 16 + fr) * 72 + ks * 32 + fq * 8);
                    u32x4 sw; sw.x = pk(Sacc[2 * ks][0], Sacc[2 * ks][1]); sw.y = pk(Sacc[2 * ks][2], Sacc[2 * ks][3]);
                    sw.z = pk(Sacc[2 * ks + 1][0], Sacc[2 * ks + 1][1]); sw.w = pk(Sacc[2 * ks + 1][2], Sacc[2 * ks + 1][3]);
                    sb[ks] = __builtin_bit_cast(bf16x8, sw);
                }
#pragma unroll
                for (int it = 0; it < 4; ++it) {
                    f32x4 o = {0.f, 0.f, 0.f, 0.f};
#pragma unroll
                    for (int ks = 0; ks < 2; ++ks) {
                        const bf16x8 aa = *(const bf16x8*)(Am + (it * 16 + fr) * 72 + ks * 32 + fq * 8);
                        o = mfma16(aa, vf[ks], o);
                        const s16x4 q0 = *(const s16x4*)(qin + (it * 16 + fr) * 72 + ks * 32 + fq * 4), q1 = *(const s16x4*)(qin + (it * 16 + fr) * 72 + ks * 32 + 16 + fq * 4);
                        const bf16x8 aq = __builtin_shufflevector(q0, q1, 0, 1, 2, 3, 4, 5, 6, 7);
                        o = mfma16(aq, sb[ks], o);
                    }
#pragma unroll
                    for (int r = 0; r < 4; ++r) { const int iloc = c * 64 + it * 16 + fq * 4 + r; const int tr = dir == 0 ? iloc : T - 1 - iloc;
                        odir[((size_t)dir * M + rowbase + tr) * 512 + hd * 128 + w * 16 + fr] = o[r]; }
                }
#pragma unroll
                for (int dt = 0; dt < 4; ++dt) {
                    f32x4 acc;
#pragma unroll
                    for (int r = 0; r < 4; ++r) acc[r] = Sacc[dt][r] * __expf(bL[63 * 65 + dt * 16 + fq * 4 + r]);
#pragma unroll
                    for (int ks = 0; ks < 2; ++ks) { const bf16x8 ak = *(const bf16x8*)(kstT + (dt * 16 + fr) * 72 + ks * 32 + fq * 8); acc = mfma16(ak, vf[ks], acc); }
                    Sacc[dt] = acc;
                }
            }
            __syncthreads();
        }
        if (!ctx && split && part < 2) {
#pragma unroll
            for (int dt = 0; dt < 4; ++dt) *(f32x4*)(gst + ((size_t)j * 512 + tid) * 16 + dt * 4) = Sacc[dt];
        }
        if (ctx) {
#pragma unroll
            for (int dt = 0; dt < 4; ++dt)
#pragma unroll
                for (int r = 0; r < 4; ++r) p.out[O_GLA + sidx + (size_t)(dt * 16 + fq * 4 + r) * 128 + w * 16 + fr] = Sacc[dt][r];
        }
    }
}

DI void phase_gla_finish(const P& p, int i) {
    const bf16_t* proj = (const bf16_t*)(p.ws + W_PROJ); const float* odir = (const float*)(p.ws + W_ODIR); bf16_t* mix = (bf16_t*)(p.ws + W_MIX);
    const float* og = p.in[19] + i * 128;
    const int tid_ = tid_o(); const int wave = bid_o() * 8 + (tid_ >> 6), nw = gridDim.x * 8, lane = tid_ & 63;
    for (int row = wave; row < M; row += nw) {
        const float* of = odir + (size_t)row * 512 + lane * 8; const float* ob = of + (size_t)M * 512;
        const f32x4 a0 = __builtin_nontemporal_load((const f32x4*)of) + __builtin_nontemporal_load((const f32x4*)ob), a1 = __builtin_nontemporal_load((const f32x4*)(of + 4)) + __builtin_nontemporal_load((const f32x4*)(ob + 4));
        float x[8] = {a0[0], a0[1], a0[2], a0[3], a1[0], a1[1], a1[2], a1[3]};
        float ss = 0.f;
#pragma unroll
        for (int e = 0; e < 8; ++e) ss += x[e] * x[e];
        ss += __shfl_xor(ss, 1); ss += __shfl_xor(ss, 2); ss += __shfl_xor(ss, 4); ss += __shfl_xor(ss, 8);
        const float rstd = rsqrtf(ss * (1.f / 128.f) + EPS);
        const u32x4 ru = *(const u32x4*)(proj + (size_t)row * 2304 + 1024 + lane * 8);
        float rv[8] = {bflo(ru.x), bfhi(ru.x), bflo(ru.y), bfhi(ru.y), bflo(ru.z), bfhi(ru.z), bflo(ru.w), bfhi(ru.w)};
        const int gc = (lane & 15) * 8;
#pragma unroll
        for (int e = 0; e < 8; ++e) x[e] = x[e] * rstd * og[gc + e] * silu_f(rv[e]);
        u32x4 w; w.x = pk(x[0], x[1]); w.y = pk(x[2], x[3]); w.z = pk(x[4], x[5]); w.w = pk(x[6], x[7]);
        *(u32x4*)(mix + (size_t)row * 1024 + lane * 8) = w;
    }
}

constexpr int NPHASE = 2 + 9 + 6 + 9 + 6;

DI void run_phase(const P& p, int ph, char* shm) {
    const int bid = bid_o(); const int G = (int)gridDim.x;
    char* ws = p.ws;
    if (ph == 0) {
        {   float* rss = (float*)(ws + W_RSS) + M; const int tid = tid_o();
            for (int k = bid * NTH + tid; k < 7 * M; k += G * NTH) rss[k] = 0.f; }
        if (G == 256) { if (bid < 96) prep_layer(p, 0, 4, bid, 96, shm); else prep_layer(p, 0, 1, bid - 96, 160, shm); }
        else prep_layer(p, 0, 7, bid, G, shm);
        if (G != 256) { for (int ll = 1; ll < 4; ++ll) prep_layer(p, ll, 7, bid, G, shm); }
        return; }
    if (ph == 1) { phase_first(p); return; }
    int l, s; { const int q = ph - 2; if (q < 9) { l = 0; s = q; } else if (q < 15) { l = 1; s = q - 9; } else if (q < 24) { l = 2; s = q - 15; } else { l = 3; s = q - 24; } }
    const int i = l >> 1; const bool isab = (l & 1) == 0;
    enum { OP_INPROJ, OP_ABPREP, OP_MLAGEMM, OP_MLAPREP, OP_GLAATTN, OP_GLAFIN, OP_OUTPROJ, OP_FFNIN, OP_FFNOUT, OP_GQAPREP, OP_GQAATTN };
    int op;
    if (isab) {
        switch (s) { case 0: op = OP_INPROJ; break; case 1: op = OP_ABPREP; break; case 2: op = OP_MLAGEMM; break; case 3: op = OP_MLAPREP; break;
            case 4: op = OP_GLAATTN; break; case 5: op = OP_GLAFIN; break; case 6: op = OP_OUTPROJ; break; case 7: op = OP_FFNIN; break; default: op = OP_FFNOUT; break; }
    } else {
        switch (s) { case 0: op = OP_INPROJ; break; case 1: op = OP_GQAPREP; break; case 2: op = OP_GQAATTN; break; case 3: op = OP_OUTPROJ; break;
            case 4: op = OP_FFNIN; break; default: op = OP_FFNOUT; break; }
    }
    const float* rssb = (const float*)(ws + W_RSS);
    switch (op) {
    case OP_ABPREP: phase_ab_prep(p, i); break;
    case OP_MLAPREP: if (G == 256) { if (bid < 16) phase_gla(p, i, shm, 1); else phase_mla_prep(p, i, bid - 16, 240, shm); } else phase_mla_prep(p, i, bid, G, shm); break;
    case OP_GQAPREP: phase_gqa_prep(p, i, shm); break;
    case OP_GLAATTN: phase_gla(p, i, shm, 2); phase_attn2<96, 8, 8, 512>(p, shm, 128); break;
    case OP_GQAATTN: phase_attn2<64, 16, 4, 0>(p, shm, 0); break;
    case OP_GLAFIN: phase_gla_finish(p, i); break;
    case OP_INPROJ: {
        EpiBfN E; E.O = (bf16_t*)(ws + W_PROJ); E.rss = rssb + (size_t)(2 * l) * M; E.bias = (const float*)(ws + W_BIASI) + (size_t)l * 3 * 2304;
        const bf16_t* Bt; int N;
        if (isab) { Bt = (const bf16_t*)(ws + W_ABI) + (size_t)i * 2304 * 1024; N = 2304; } else { Bt = (const bf16_t*)(ws + W_GQI) + (size_t)i * 1536 * 1024; N = 1536; }
        E.ldc = N; E.gs = N;
        run_gemm<EpiBfN>(shm, (const bf16_t*)(ws + W_H), Bt, M, N, 1024, bid, E);
        if (l == 0 && bid >= 104 && G == 256) prep_layer(p, 0, 2, bid - 104, 152, shm);
        else if (l == 0 && G != 256) prep_layer(p, 0, 0, bid, G, shm);
    } break;
    case OP_MLAGEMM: {
        if (G == 256 && bid < 16) { phase_gla(p, i, shm, 0); break; }
        const int Gv = G == 256 ? 240 : G, vb = G == 256 ? bid - 16 : bid;
        for (int q = 0; q < 2; ++q) {
            const bf16_t* A; const bf16_t* Bt; int Mr, N, K, c = vb; EpiBf E;
            if (q == 0) { A = (const bf16_t*)(ws + W_CQN); Bt = (const bf16_t*)(ws + W_QB) + (size_t)i * 768 * 384; Mr = M; N = 768; K = 384; E.O = (bf16_t*)(ws + W_QM); E.ldc = 768; }
            else { A = (const bf16_t*)(ws + W_CKVN); Bt = (const bf16_t*)(ws + W_KVB) + (size_t)i * 1024 * 256; Mr = MKV; N = 1024; K = 256; E.O = (bf16_t*)(ws + W_KVM); E.ldc = 1024;
                c = (vb + Gv - 120) % Gv; }
            run_gemm<EpiBf>(shm, A, Bt, Mr, N, K, c, E, Gv);
        }
    } break;
    case OP_OUTPROJ: case OP_FFNOUT: {
        const bf16_t* A; const bf16_t* Bt; int K; EpiResN E; E.X = p.out; E.S0 = p.out; E.S1 = p.out + (size_t)MC * 1024; E.H = (bf16_t*)(ws + W_H);
        const float* modb = (const float*)(ws + W_MOD);
        const float* mod = modb + (size_t)l * 6144;
        if (op == OP_OUTPROJ) { A = (const bf16_t*)(ws + W_MIX); K = 1024; Bt = isab ? (const bf16_t*)(ws + W_ABO) + (size_t)i * 1024 * 1024 : (const bf16_t*)(ws + W_GQO) + (size_t)i * 1024 * 1024; E.gate = mod + 2048;
            if (l == 0) { E.S0 = p.in[0]; E.S1 = p.in[1]; }
            E.gn = p.in[12] + l * 1024; E.scn = mod + 4096; E.rssn = (float*)(ws + W_RSS) + (size_t)(2 * l + 1) * M; }
        else { A = (const bf16_t*)(ws + W_FFNH); K = 2816; Bt = (const bf16_t*)(ws + W_FFO) + (size_t)l * 1024 * 2816; E.gate = mod + 5120;
            if (l < 3) { E.gn = p.in[11] + (l + 1) * 1024; E.scn = modb + (size_t)(l + 1) * 6144 + 1024; E.rssn = (float*)(ws + W_RSS) + (size_t)(2 * l + 2) * M; }
            else { E.H = nullptr; E.gn = p.in[11]; E.scn = modb; E.rssn = nullptr; } }
        if (bid >= 160 && G == 256) {
            const int vw = (bid - 160) * 8 + (tid_o() >> 6);
            if (op == OP_OUTPROJ) { if (l < 3) prep_layer(p, l + 1, 1, bid - 160, 96, shm); bias_ffn(p, l, vw, 96 * 8); }
            else if (l < 3) { prep_layer(p, l + 1, 2, bid - 160, 96, shm); bias_in(p, l + 1, vw, 96 * 8); }
        } else run_gemm<EpiResN>(shm, A, Bt, M, 1024, K, bid, E);
    } break;
    case OP_FFNIN: {
        EpiSwiN E; E.O = (bf16_t*)(ws + W_FFNH); E.rss = rssb + (size_t)(2 * l + 1) * M; E.bias = (const float*)(ws + W_BIASF) + (size_t)l * 3 * 5632;
        run_gemm<EpiSwiN>(shm, (const bf16_t*)(ws + W_H), (const bf16_t*)(ws + W_FFI) + (size_t)l * 5632 * 1024, M, 5632, 1024, bid, E);
        if (l < 3 && bid >= 112 && G == 256) prep_layer(p, l + 1, 4, bid - 112, 144, shm);
    } break;
    }
}

template <bool COOP>
__global__ __launch_bounds__(512, 2) void mega(P p, int ph0, int ph1) {
    extern __shared__ __attribute__((aligned(16))) char shm[];
    __shared__ uint4 xb_words;
    XcdBarrier xb;
    if (COOP) {
        if (ph1 < 0) cg::this_grid().sync();
        if (threadIdx.x == 0) xb_words = make_uint4(0u, 0u, 0u, 0u);
        __syncthreads();
        xb = xcd_barrier_post((unsigned*)(p.ws + W_BAR), (volatile LAS unsigned*)&xb_words);
    }
    for (int ph = ph0; ph < ph1; ++ph) {
        run_phase(p, ph, shm);
        if (COOP) { if (ph + 1 < ph1) xcd_barrier(xb); }
    }
}

extern "C" void kernel_launch(void* const* d_in, const int* in_sizes, int n_in, void* d_out, int out_size, void* d_ws, size_t ws_size, hipStream_t stream) {
    static int grid = 0;
    if (grid == 0) {
        int dev = 0, cus = 0, per_cu = 0;
        hipGetDevice(&dev);
        hipDeviceGetAttribute(&cus, hipDeviceAttributeMultiprocessorCount, dev);
        hipFuncSetAttribute((const void*)mega<true>, hipFuncAttributeMaxDynamicSharedMemorySize, LDS_BYTES);
        hipFuncSetAttribute((const void*)mega<false>, hipFuncAttributeMaxDynamicSharedMemorySize, LDS_BYTES);
        hipOccupancyMaxActiveBlocksPerMultiprocessor(&per_cu, (const void*)mega<true>, NTH, LDS_BYTES);
        if (per_cu < 1) per_cu = 1;
        grid = cus * per_cu;
        if (grid > 256) grid = 256;
        (void)hipGetLastError();
        if (ws_size < W_END2) fprintf(stderr, "kernel_launch: workspace too small: %zu < %zu\n", ws_size, (size_t)W_END2);
    }
    P p{};
    for (int k = 0; k < 30; ++k) p.in[k] = (const float*)d_in[k];
    p.out = (float*)d_out; p.ws = (char*)d_ws;
#if MULTI_LAUNCH
    for (int ph = 0; ph < NPHASE; ++ph) hipLaunchKernelGGL(mega<false>, dim3(grid), dim3(NTH), LDS_BYTES, stream, p, ph, ph + 1);
#else
    (void)hipMemsetAsync((char*)d_ws + W_BAR, 0, 16384, stream);
    int ph0 = 0, ph1 = NPHASE;
    void* args[] = {&p, &ph0, &ph1};
    hipError_t e = hipLaunchCooperativeKernel((const void*)mega<true>, dim3(grid), dim3(NTH), args, LDS_BYTES, stream);
    if (e != hipSuccess) fprintf(stderr, "cooperative launch failed: %s (grid %d)\n", hipGetErrorString(e), grid);
#endif
}
```
